# Optimizing an MI355X kernel written in HIP

```python
import jax, jax.numpy as jnp
from jax import lax
import numpy as np

D_MODEL = 1024
BATCH = 8
SEQ = 4096
DEPTH = 4
DEC_BATCH = 8
DEC_SEQ = 64
PAST_LEN = 2048

CHUNK = 64
D_MIX = D_MODEL
D_CONV = D_MIX // 2
D_POOL = D_MIX - D_CONV
CONV_WIDTH = 31
POOL_WINDOWS = (2, 4, 8, 16)
N_POOL_GROUPS = len(POOL_WINDOWS)
POOL_GROUP = D_POOL // N_POOL_GROUPS
MAX_POOL = max(POOL_WINDOWS)
D_FF = 4 * D_MODEL
PLE_DIM = 256
EPS = 1e-6

kernel_name = "hybrid_conv_pool_stream_step"


def _rmsnorm(x, g):
    xf = x.astype(jnp.float32)
    r = xf * lax.rsqrt(jnp.mean(xf * xf, axis=-1, keepdims=True) + EPS)
    return (r * g.astype(jnp.float32)).astype(x.dtype)


def _layernorm(x, g, b):
    xf = x.astype(jnp.float32)
    mu = jnp.mean(xf, axis=-1, keepdims=True)
    var = jnp.mean(jnp.square(xf - mu), axis=-1, keepdims=True)
    y = (xf - mu) * lax.rsqrt(var + EPS) * g.astype(jnp.float32) + b.astype(jnp.float32)
    return y.astype(x.dtype)


def _layer(x, p, conv_buf, pool_buf, pos0, w_in, conv_w, conv_b, ln_g, ln_b, pool_w, pool_scale,
           w_out, g_mix, g_ffn, g_ple, w_ff1, w_ff2, w_ple, w_gate):
    B, L, _ = x.shape
    h = _rmsnorm(x, g_mix)
    z = h @ w_in
    a = z[..., :D_CONV]
    gt = z[..., D_CONV:2 * D_CONV]
    u = z[..., 2 * D_CONV:]

    c = a * jax.nn.sigmoid(gt)
    c_pad = jnp.concatenate([conv_buf.astype(c.dtype), c], axis=1)
    cv = lax.conv_general_dilated(
        c_pad, conv_w[:, None, :].astype(c.dtype), (1,), 'VALID',
        dimension_numbers=('NWC', 'WIO', 'NWC'), feature_group_count=D_CONV)
    cv = cv + conv_b
    cv = _layernorm(cv, ln_g, ln_b)
    cv = cv * jax.nn.sigmoid(cv)
    new_conv = c_pad[:, -(CONV_WIDTH - 1):]

    u_pad = jnp.concatenate([pool_buf.astype(u.dtype), u], axis=1)
    new_pool = u_pad[:, -(MAX_POOL - 1):]
    uf = u_pad.astype(jnp.float32)
    csum = jnp.concatenate([jnp.zeros((B, 1, D_POOL), jnp.float32), jnp.cumsum(uf, axis=1)], axis=1)
    csum = csum.reshape(B, L + MAX_POOL, N_POOL_GROUPS, POOL_GROUP)
    pos = pos0 + jnp.arange(L)
    means = []
    for g, w in enumerate(POOL_WINDOWS):
        s = csum[:, MAX_POOL:, g] - csum[:, MAX_POOL - w:MAX_POOL - w + L, g]
        cnt = jnp.minimum(w, pos + 1).astype(jnp.float32)
        means.append(s / cnt[None, :, None])
    pooled = jnp.stack(means, axis=2)
    d = pooled - uf[:, MAX_POOL - 1:].reshape(B, L, N_POOL_GROUPS, POOL_GROUP)
    pm = jnp.einsum('blgc,gcd->blgd', d.astype(x.dtype), pool_w).reshape(B, L, D_POOL) * pool_scale

    x = x + jnp.concatenate([cv.astype(x.dtype), pm.astype(x.dtype)], axis=-1) @ w_out

    h2 = _rmsnorm(x, g_ffn)
    x = x + jnp.square(jax.nn.relu(h2 @ w_ff1)) @ w_ff2

    gate = jax.nn.sigmoid(_rmsnorm(x, g_ple) @ w_gate)
    x = x + gate * (p @ w_ple)
    return x, new_conv, new_pool


def _trunk(x, p, conv_bufs, pool_bufs, pos0, w_in, conv_w, conv_b, ln_g, ln_b, pool_w, pool_scale,
           w_out, g_mix, g_ffn, g_ple, w_ff1, w_ff2, w_ple, w_gate, g_final):
    new_convs, new_pools = [], []
    for i in range(DEPTH):
        x, nc, npl = _layer(x, p[i], conv_bufs[i], pool_bufs[i], pos0, w_in[i], conv_w[i], conv_b[i],
                            ln_g[i], ln_b[i], pool_w[i], pool_scale[i], w_out[i], g_mix[i], g_ffn[i],
                            g_ple[i], w_ff1[i], w_ff2[i], w_ple[i], w_gate[i])
        new_convs.append(nc)
        new_pools.append(npl)
    return _rmsnorm(x, g_final), jnp.stack(new_convs, 0), jnp.stack(new_pools, 0)


def setup_inputs(seed: int = 0) -> dict:
    key = jax.random.key(seed)
    ks = jax.random.split(key, 24)
    f32 = jnp.float32
    nrm = lambda k, s, sc: (jax.random.normal(k, s, f32) * sc).astype(f32)
    return {
        "x_prompt": nrm(ks[0], (BATCH, SEQ, D_MODEL), 1.0),
        "x_sample": nrm(ks[1], (DEC_BATCH, DEC_SEQ, D_MODEL), 1.0),
        "p_prompt": nrm(ks[2], (DEPTH, BATCH, SEQ, PLE_DIM), 1.0),
        "p_sample": nrm(ks[3], (DEPTH, DEC_BATCH, DEC_SEQ, PLE_DIM), 1.0),
        "cache_conv": nrm(ks[4], (DEPTH, DEC_BATCH, CONV_WIDTH - 1, D_CONV), 1.0),
        "cache_pool": nrm(ks[5], (DEPTH, DEC_BATCH, MAX_POOL - 1, D_POOL), 1.0),
        "w_in": nrm(ks[6], (DEPTH, D_MODEL, 2 * D_CONV + D_POOL), D_MODEL ** -0.5),
        "conv_w": nrm(ks[7], (DEPTH, CONV_WIDTH, D_CONV), CONV_WIDTH ** -0.5),
        "conv_b": nrm(ks[8], (DEPTH, D_CONV), 0.02),
        "ln_g": 1.0 + nrm(ks[9], (DEPTH, D_CONV), 0.05),
        "ln_b": nrm(ks[10], (DEPTH, D_CONV), 0.02),
        "pool_w": nrm(ks[11], (DEPTH, N_POOL_GROUPS, POOL_GROUP, POOL_GROUP), POOL_GROUP ** -0.5),
        "pool_scale": 1.0 + nrm(ks[12], (DEPTH, D_POOL), 0.05),
        "w_out": nrm(ks[13], (DEPTH, D_MIX, D_MODEL), D_MIX ** -0.5),
        "g_mix": 1.0 + nrm(ks[14], (DEPTH, D_MODEL), 0.05),
        "g_ffn": 1.0 + nrm(ks[15], (DEPTH, D_MODEL), 0.05),
        "g_ple": 1.0 + nrm(ks[16], (DEPTH, D_MODEL), 0.05),
        "w_ff1": nrm(ks[17], (DEPTH, D_MODEL, D_FF), D_MODEL ** -0.5),
        "w_ff2": nrm(ks[18], (DEPTH, D_FF, D_MODEL), D_FF ** -0.5),
        "w_ple": nrm(ks[19], (DEPTH, PLE_DIM, D_MODEL), PLE_DIM ** -0.5),
        "w_gate": nrm(ks[20], (DEPTH, D_MODEL, D_MODEL), D_MODEL ** -0.5),
        "g_final": 1.0 + nrm(ks[21], (D_MODEL,), 0.05),
    }


def reference(x_prompt, x_sample, p_prompt, p_sample, cache_conv, cache_pool, w_in, conv_w, conv_b,
              ln_g, ln_b, pool_w, pool_scale, w_out, g_mix, g_ffn, g_ple, w_ff1, w_ff2, w_ple, w_gate,
              g_final):
    B = x_prompt.shape[0]
    zero_conv = jnp.zeros((DEPTH, B, CONV_WIDTH - 1, D_CONV), x_prompt.dtype)
    zero_pool = jnp.zeros((DEPTH, B, MAX_POOL - 1, D_POOL), x_prompt.dtype)
    y_prompt, new_conv_prompt, new_pool_prompt = _trunk(
        x_prompt, p_prompt, zero_conv, zero_pool, 0, w_in, conv_w, conv_b, ln_g, ln_b, pool_w,
        pool_scale, w_out, g_mix, g_ffn, g_ple, w_ff1, w_ff2, w_ple, w_gate, g_final)
    y_sample, new_conv_sample, new_pool_sample = _trunk(
        x_sample, p_sample, cache_conv, cache_pool, PAST_LEN, w_in, conv_w, conv_b, ln_g, ln_b, pool_w,
        pool_scale, w_out, g_mix, g_ffn, g_ple, w_ff1, w_ff2, w_ple, w_gate, g_final)
    return (y_prompt, y_sample, new_conv_prompt, new_pool_prompt, new_conv_sample, new_pool_sample)
```

```cpp
#include <hip/hip_runtime.h>
#include <hip/hip_cooperative_groups.h>
#include <cstdio>
#include <cstdint>
namespace cg = cooperative_groups;
namespace pg8 {
#define PG8_LAS __attribute__((address_space(3)))
typedef unsigned short bf16_t;
typedef short bf16x8 __attribute__((ext_vector_type(8)));
typedef float f32x4 __attribute__((ext_vector_type(4)));
typedef unsigned u32x4 __attribute__((ext_vector_type(4)));
constexpr int BM = 256, BK = 64, HALF = 128, HTB = HALF * BK * 2  , STAGE_BYTES = 8 * HTB, NXCD = 8, WGM = 8;

__host__ __device__ __forceinline__ int lds_byte(int r, int c) { const int st = (r >> 4) * 2 + (c >> 5), rr = r & 15, cc = c & 31, ob = rr * 64 + cc * 2; return st * 1024 + (ob ^ (((ob >> 9) & 1) << 5)); }
__host__ __device__ __forceinline__ void stage_rc(int b, int& R, int& C) { const int st = b / 1024, sb = b % 1024, swz = sb ^ (((sb >> 9) & 1) << 5); R = (st >> 1) * 16 + swz / 64; C = (st & 1) * 32 + (swz % 64) / 2; }
__host__ __device__ __forceinline__ int perm32(int rho) { const int n = rho >> 4, i = rho & 15; return 8 * (i >> 2) + 4 * n + (i & 3); }

struct Unit { int pm, pn; };
struct Gemm { const bf16_t* A; const bf16_t* Bt; int M, N, K; };

struct StaticOrder {
    int nM, nN, nwg, G, c;
    __host__ __device__ void init(int M, int N, int G_, int c_) { nM = M / BM; nN = N / BM; nwg = nM * nN; G = G_; c = c_; }
    __host__ __device__ bool next(int i, Unit& u) const {
        const long L = (long)i * G + c; if (L >= nwg) return false;
        int wgid = (int)L; { const int q = nwg / NXCD, r = nwg % NXCD, xcd = wgid % NXCD, off = wgid / NXCD; wgid = (xcd < r ? xcd * (q + 1) : r * (q + 1) + (xcd - r) * q) + off; }
        const int nig = WGM * nN, gid = wgid / nig, fm = gid * WGM, gsz = (nM - fm) < WGM ? (nM - fm) : WGM;
        u.pm = fm + ((wgid % nig) % gsz); u.pn = (wgid % nig) / gsz; return true;
    }
    __device__ __forceinline__ void a_ready(const Unit&) const {}
    __device__ __forceinline__ void done(const Unit&) const {}
};
constexpr int E_MP = 32768;
__device__ __forceinline__ unsigned cvt_pk_bf16(float lo, float hi) { unsigned r; asm volatile("v_cvt_pk_bf16_f32 %0, %1, %2" : "=v"(r) : "v"(lo), "v"(hi)); return r; }
__device__ __forceinline__ float sigm(float x) { return __builtin_amdgcn_rcpf(1.0f + __expf(-x)); }
__device__ __forceinline__ u32x4 pack8(const f32x4 v0, const f32x4 v1) { u32x4 w; w.x = cvt_pk_bf16(v0[0], v0[1]); w.y = cvt_pk_bf16(v0[2], v0[3]); w.z = cvt_pk_bf16(v1[0], v1[1]); w.w = cvt_pk_bf16(v1[2], v1[3]); return w; }
typedef unsigned long long ssq_t;
__device__ __forceinline__ float rs_of(const ssq_t* ssq, int r) { return rsqrtf((float)ssq[r] * (1.0f / (1024.0f * 1048576.0f)) + 1e-6f); }
__device__ __forceinline__ float rs_from(ssq_t v) { return rsqrtf((float)v * (1.0f / (1024.0f * 1048576.0f)) + 1e-6f); }
__device__ __forceinline__ void ssq_add(ssq_t* p, float ss) { atomicAdd(p, (ssq_t)(ss * 1048576.0f)); }

struct EpiGLU {
    static constexpr bool PERM = true, AFTER_DRAIN = false;
    bf16_t* C; bf16_t* U; const ssq_t* ssq;
    __device__ __forceinline__ void operator()(const f32x4 (&acc)[2][2][4][2], const Unit& u, int wr, int wc, int fr0, int fq0) const {
        int fr = fr0, fq = fq0; asm volatile("" : "+v"(fr), "+v"(fq));
        const int row0 = u.pm * BM + wr * 64 + fr;
        if (u.pn < 4) {
            const int ch0 = u.pn * 128 + wc * 32 + 8 * fq;
#pragma unroll
            for (int ai = 0; ai < 2; ++ai)
#pragma unroll
                for (int m = 0; m < 4; ++m) { const int r = row0 + ai * HALF + m * 16; const float rsv = rs_of(ssq, r);
                    f32x4 c0, c1;
#pragma unroll
                    for (int j = 0; j < 4; ++j) { c0[j] = (acc[ai][0][m][0][j] * rsv) * sigm(acc[ai][1][m][0][j] * rsv); c1[j] = (acc[ai][0][m][1][j] * rsv) * sigm(acc[ai][1][m][1][j] * rsv); }
                    *(u32x4*)(C + (size_t)r * 512 + ch0) = pack8(c0, c1); }
        } else {
            const int uc0 = (u.pn - 4) * 256 + wc * 32 + 8 * fq;
#pragma unroll
            for (int ai = 0; ai < 2; ++ai)
#pragma unroll
                for (int m = 0; m < 4; ++m) { const int r = row0 + ai * HALF + m * 16; const float rsv = rs_of(ssq, r);
#pragma unroll
                    for (int bj = 0; bj < 2; ++bj) *(u32x4*)(U + (size_t)r * 512 + uc0 + bj * HALF) = pack8(acc[ai][bj][m][0] * rsv, acc[ai][bj][m][1] * rsv); }
        }
    }
};
__device__ __forceinline__ void unpack8(const u32x4 w, f32x4& a, f32x4& b) {
    a[0] = __uint_as_float(w.x << 16); a[1] = __uint_as_float(w.x & 0xffff0000u); a[2] = __uint_as_float(w.y << 16); a[3] = __uint_as_float(w.y & 0xffff0000u);
    b[0] = __uint_as_float(w.z << 16); b[1] = __uint_as_float(w.z & 0xffff0000u); b[2] = __uint_as_float(w.w << 16); b[3] = __uint_as_float(w.w & 0xffff0000u); }
__device__ __forceinline__ float sumsq8(const f32x4 a, const f32x4 b) { return (a[0] * a[0] + a[1] * a[1]) + (a[2] * a[2] + a[3] * a[3]) + (b[0] * b[0] + b[1] * b[1]) + (b[2] * b[2] + b[3] * b[3]); }
__device__ __forceinline__ void ssq_add8(ssq_t* ssq_out, const float (&ss)[8], int row0, int fr, int fq) {
#pragma unroll
    for (int e = 0; e < 2; ++e) { const float v = fq == 0 ? ss[e] : (fq == 1 ? ss[2 + e] : (fq == 2 ? ss[4 + e] : ss[6 + e])); const int idx = 2 * fq + e;
        ssq_add(ssq_out + row0 + (idx >> 2) * HALF + (idx & 3) * 16, v); }
}
struct EpiRes {
    static constexpr bool PERM = true, AFTER_DRAIN = false;
    const bf16_t* base; bf16_t* XB; ssq_t* ssq_out;
    __device__ __forceinline__ void operator()(const f32x4 (&acc)[2][2][4][2], const Unit& u, int wr, int wc, int fr0, int fq0) const {
        int fr = fr0, fq = fq0; asm volatile("" : "+v"(fr), "+v"(fq));
        const int row0 = u.pm * BM + wr * 64 + fr, col0 = u.pn * BM + wc * 32 + 8 * fq;
        float ssv[8];
        u32x4 bw[2][4][2];
#pragma unroll
        for (int m = 0; m < 4; ++m)
#pragma unroll
            for (int bj = 0; bj < 2; ++bj) bw[0][m][bj] = *(const u32x4*)(base + (size_t)(row0 + m * 16) * 1024 + col0 + bj * HALF);
#pragma unroll
        for (int m = 0; m < 2; ++m)
#pragma unroll
            for (int bj = 0; bj < 2; ++bj) bw[1][m][bj] = *(const u32x4*)(base + (size_t)(row0 + HALF + m * 16) * 1024 + col0 + bj * HALF);
        __builtin_amdgcn_sched_barrier(0);
#pragma unroll
        for (int ai = 0; ai < 2; ++ai) {
#pragma unroll
            for (int m = 0; m < 4; ++m) { const int r = row0 + ai * HALF + m * 16; float ss = 0.f;
#pragma unroll
                for (int bj = 0; bj < 2; ++bj) { const size_t off = (size_t)r * 1024 + col0 + bj * HALF;
                    f32x4 b0, b1; unpack8(bw[ai][m][bj], b0, b1);
                    const u32x4 w = pack8(b0 + acc[ai][bj][m][0], b1 + acc[ai][bj][m][1]); *(u32x4*)(XB + off) = w;
                    unpack8(w, b0, b1); ss += sumsq8(b0, b1); }
                ss += __shfl_xor(ss, 16); ss += __shfl_xor(ss, 32);
                ssv[ai * 4 + m] = ss;
                if (ai == 0 && m == 1) {
                    __builtin_amdgcn_sched_barrier(0);
#pragma unroll
                    for (int m2 = 2; m2 < 4; ++m2)
#pragma unroll
                        for (int bj = 0; bj < 2; ++bj) bw[1][m2][bj] = *(const u32x4*)(base + (size_t)(row0 + HALF + m2 * 16) * 1024 + col0 + bj * HALF);
                    __builtin_amdgcn_sched_barrier(0); } }
        }
        ssq_add8(ssq_out, ssv, u.pm * BM + wr * 64 + fr, fr, fq);
        __builtin_amdgcn_sched_barrier(0);
    }
};
struct EpiRelu2 {
    static constexpr bool PERM = true, AFTER_DRAIN = false;
    bf16_t* H; const ssq_t* ssq;
    __device__ __forceinline__ void operator()(const f32x4 (&acc)[2][2][4][2], const Unit& u, int wr, int wc, int fr0, int fq0) const {
        int fr = fr0, fq = fq0; asm volatile("" : "+v"(fr), "+v"(fq));
        const int row0 = u.pm * BM + wr * 64 + fr, col0 = u.pn * BM + wc * 32 + 8 * fq;
#pragma unroll
        for (int ai = 0; ai < 2; ++ai)
#pragma unroll
            for (int m = 0; m < 4; ++m) { const int r = row0 + ai * HALF + m * 16; const float rsv = rs_of(ssq, r);
#pragma unroll
                for (int bj = 0; bj < 2; ++bj) { f32x4 v0 = acc[ai][bj][m][0] * rsv, v1 = acc[ai][bj][m][1] * rsv;
#pragma unroll
                    for (int j = 0; j < 4; ++j) { v0[j] = fmaxf(v0[j], 0.f); v1[j] = fmaxf(v1[j], 0.f); }
                    *(u32x4*)(H + (size_t)r * 4096 + col0 + bj * HALF) = pack8(v0 * v0, v1 * v1); } }
    }
};
struct EpiQ {
    static constexpr bool PERM = true, AFTER_DRAIN = false;
    bf16_t* Q;
    __device__ __forceinline__ void operator()(const f32x4 (&acc)[2][2][4][2], const Unit& u, int wr, int wc, int fr0, int fq0) const {
        int fr = fr0, fq = fq0; asm volatile("" : "+v"(fr), "+v"(fq));
        const int row0 = u.pm * BM + wr * 64 + fr, col0 = u.pn * BM + wc * 32 + 8 * fq;
#pragma unroll
        for (int ai = 0; ai < 2; ++ai)
#pragma unroll
            for (int m = 0; m < 4; ++m) { const int r = row0 + ai * HALF + m * 16;
#pragma unroll
                for (int bj = 0; bj < 2; ++bj) *(u32x4*)(Q + (size_t)r * 1024 + col0 + bj * HALF) = pack8(acc[ai][bj][m][0], acc[ai][bj][m][1]); }
    }
};
struct EpiGate {
    static constexpr bool PERM = true, AFTER_DRAIN = false;
    const bf16_t* Q; const bf16_t* XBin; bf16_t* XBout; const ssq_t* ssq; ssq_t* ssq_out;
    __device__ __forceinline__ void operator()(const f32x4 (&acc)[2][2][4][2], const Unit& u, int wr, int wc, int fr0, int fq0) const {
        int fr = fr0, fq = fq0; asm volatile("" : "+v"(fr), "+v"(fq));
        const int row0 = u.pm * BM + wr * 64 + fr, col0 = u.pn * BM + wc * 32 + 8 * fq;
        float ssv[8];
#pragma unroll
        for (int ai = 0; ai < 2; ++ai) {
            u32x4 qw[4][2], xw[4][2]; ssq_t sq[4];
#pragma unroll
            for (int m = 0; m < 4; ++m) { sq[m] = ssq[row0 + ai * HALF + m * 16];
#pragma unroll
                for (int bj = 0; bj < 2; ++bj) { const size_t off = (size_t)(row0 + ai * HALF + m * 16) * 1024 + col0 + bj * HALF; qw[m][bj] = *(const u32x4*)(Q + off); xw[m][bj] = *(const u32x4*)(XBin + off); } }
            __builtin_amdgcn_sched_barrier(0);
#pragma unroll
            for (int m = 0; m < 4; ++m) { const int r = row0 + ai * HALF + m * 16; const float rsv = rsqrtf((float)sq[m] * (1.0f / (1024.0f * 1048576.0f)) + 1e-6f); float ss = 0.f;
#pragma unroll
                for (int bj = 0; bj < 2; ++bj) { const size_t off = (size_t)r * 1024 + col0 + bj * HALF;
                    f32x4 q0, q1, x0, x1; unpack8(qw[m][bj], q0, q1); unpack8(xw[m][bj], x0, x1);
                    f32x4 o0, o1;
#pragma unroll
                    for (int j = 0; j < 4; ++j) { o0[j] = x0[j] + sigm(acc[ai][bj][m][0][j] * rsv) * q0[j]; o1[j] = x1[j] + sigm(acc[ai][bj][m][1][j] * rsv) * q1[j]; }
                    const u32x4 w = pack8(o0, o1); *(u32x4*)(XBout + off) = w;
                    unpack8(w, o0, o1); ss += sumsq8(o0, o1); }
                ss += __shfl_xor(ss, 16); ss += __shfl_xor(ss, 32);
                ssv[ai * 4 + m] = ss; }
            __builtin_amdgcn_sched_barrier(0);
        }
        ssq_add8(ssq_out, ssv, row0, fr, fq);
    }
};
template <class Epi, class Sched, bool ALIGN_EPI = false, bool SP2 = false>
__device__ __forceinline__ void gemm_phase(PG8_LAS unsigned char* lds, const Gemm g, const Sched& S, const Epi& E) {
    int tid_ = threadIdx.x; asm volatile("" : "+v"(tid_));
    const int tid = tid_, wid = __builtin_amdgcn_readfirstlane(tid >> 6), lane = tid & 63, wr = wid >> 2, wc = wid & 3, fr = lane & 15, fq = lane >> 4;
    int K_ = g.K; asm volatile("" : "+s"(K_));
    const int K = K_, nt = K / BK;
    unsigned voffA[2], voffB[2];
#pragma unroll
    for (int i = 0; i < 2; ++i) { int R, C; stage_rc(tid * 16 + i * 8192, R, C); const int Rb = Epi::PERM ? ((R & ~31) + perm32(R & 31)) : R;
        voffA[i] = (unsigned)(R * K + C) * 2u; voffB[i] = (unsigned)(Rb * K + C) * 2u; }
    const size_t kstep = (size_t)(BK * 2);
    const size_t hstep = (size_t)HALF * K * 2;
    const size_t tstep = 2 * hstep;
    const unsigned ldsw = (unsigned)wid * 1024u;
    const int aoff = lds_byte(wr * 64 + fr, fq * 8), boff = lds_byte(wc * 32 + fr, fq * 8);
#define PG8_SA(b, h) (((b) * 2 + (h)) * HTB)
#define PG8_SB(b, h) ((4 + (b) * 2 + (h)) * HTB)
#define PG8_STAGE(bufoff, gbase, voff) do { _Pragma("unroll") for (int _i = 0; _i < 2; ++_i) \
        __builtin_amdgcn_global_load_lds((const unsigned*)((const char*)(gbase) + (voff)[_i]), (PG8_LAS unsigned*)(lds + (bufoff) + ldsw + _i * 8192), 16, 0, 0); } while (0)
#define PG8_LDA(dst, b, h) do { _Pragma("unroll") for (int m = 0; m < 4; ++m) _Pragma("unroll") for (int k = 0; k < 2; ++k) dst[m][k] = *(const PG8_LAS bf16x8*)(lds + PG8_SA(b, h) + aoff + m * 2048 + k * 1024); } while (0)
#define PG8_LDB(dst, b, h) do { _Pragma("unroll") for (int n = 0; n < 2; ++n) _Pragma("unroll") for (int k = 0; k < 2; ++k) dst[n][k] = *(const PG8_LAS bf16x8*)(lds + PG8_SB(b, h) + boff + n * 2048 + k * 1024); } while (0)
#define PG8_MMA(ai, bj, At, Bt) do { __builtin_amdgcn_s_setprio(1); _Pragma("unroll") for (int m = 0; m < 4; ++m) _Pragma("unroll") for (int n = 0; n < 2; ++n) _Pragma("unroll") for (int k = 0; k < 2; ++k) \
        acc[ai][bj][m][n] = __builtin_amdgcn_mfma_f32_16x16x32_bf16(Bt[n][k], At[m][k], acc[ai][bj][m][n], 0, 0, 0); __builtin_amdgcn_s_setprio(0); } while (0)
#define PG8_WAIT_V(n) asm volatile("s_waitcnt vmcnt(" #n ")" ::: "memory")
#define PG8_WAIT_L(n) asm volatile("s_waitcnt lgkmcnt(" #n ")" ::: "memory")
#define PG8_BAR __builtin_amdgcn_s_barrier()
#define PG8_SCHED __builtin_amdgcn_sched_barrier(0)
    Unit cur, nxt; int ui = 0;
    if (!S.next(0, cur)) return;
    f32x4 acc[2][2][4][2];
#pragma unroll
    for (int a = 0; a < 2; ++a)
#pragma unroll
        for (int b = 0; b < 2; ++b)
#pragma unroll
            for (int m = 0; m < 4; ++m)
#pragma unroll
                for (int n = 0; n < 2; ++n) acc[a][b][m][n] = (f32x4){0.f, 0.f, 0.f, 0.f};
    bf16x8 At[4][2], B0[2][2], B1[2][2];
    const char* cA = (const char*)g.A + (size_t)cur.pm * tstep; const char* cB = (const char*)g.Bt + (size_t)cur.pn * tstep;
    S.a_ready(cur);
    if constexpr (SP2) {
        PG8_STAGE(PG8_SB(0, 0), cB, voffB); PG8_STAGE(PG8_SB(0, 1), cB + hstep, voffB); PG8_STAGE(PG8_SA(0, 0), cA, voffA); PG8_STAGE(PG8_SA(0, 1), cA + hstep, voffA);
        if (wr == 1) PG8_BAR;
        PG8_WAIT_V(2); PG8_BAR;
        PG8_STAGE(PG8_SB(1, 0), cB + kstep, voffB); PG8_STAGE(PG8_SA(1, 0), cA + kstep, voffA); PG8_STAGE(PG8_SB(1, 1), cB + hstep + kstep, voffB);
        PG8_WAIT_V(6); PG8_BAR;
    } else {
        PG8_STAGE(PG8_SB(0, 0), cB, voffB); PG8_STAGE(PG8_SA(0, 0), cA, voffA); PG8_STAGE(PG8_SB(0, 1), cB + hstep, voffB); PG8_STAGE(PG8_SA(0, 1), cA + hstep, voffA);
        if (wr == 1) PG8_BAR;
        PG8_WAIT_V(4); PG8_BAR;
        PG8_STAGE(PG8_SB(1, 0), cB + kstep, voffB); PG8_STAGE(PG8_SA(1, 0), cA + kstep, voffA); PG8_STAGE(PG8_SB(1, 1), cB + hstep + kstep, voffB);
        PG8_WAIT_V(6); PG8_BAR;
    }
    for (;;) {
        const bool has_next = S.next(ui + 1, nxt);
        const char* nA = has_next ? (const char*)g.A + (size_t)nxt.pm * tstep : cA; const char* nB = has_next ? (const char*)g.Bt + (size_t)nxt.pn * tstep : cB;
        for (int t = 0; t < nt; t += 2) {
            const bool last = (t == nt - 2);
            const char* a1 = cA + (size_t)(t + 1) * kstep;
            const char* a2 = last ? nA : cA + (size_t)(t + 2) * kstep; const char* b2 = last ? nB : cB + (size_t)(t + 2) * kstep;
            const char* a3 = a2 + kstep; const char* b3 = b2 + kstep;
            if (last && has_next) S.a_ready(nxt);
            if constexpr (SP2) {
            PG8_LDB(B0, 0, 0); PG8_LDB(B1, 0, 1); PG8_SCHED; PG8_LDA(At, 0, 0); PG8_STAGE(PG8_SA(1, 1), a1 + hstep, voffA);
            PG8_WAIT_V(8); PG8_WAIT_L(0); PG8_BAR; PG8_MMA(0, 0, At, B0); PG8_MMA(0, 1, At, B1); PG8_BAR; PG8_SCHED;
            PG8_LDA(At, 0, 1); PG8_STAGE(PG8_SB(0, 0), b2, voffB); PG8_STAGE(PG8_SB(0, 1), b2 + hstep, voffB); PG8_STAGE(PG8_SA(0, 0), a2, voffA);
            PG8_WAIT_V(8); PG8_WAIT_L(0); PG8_BAR; PG8_MMA(1, 0, At, B0); PG8_MMA(1, 1, At, B1); PG8_BAR; PG8_SCHED;
            PG8_LDB(B0, 1, 0); PG8_LDB(B1, 1, 1); PG8_SCHED; PG8_LDA(At, 1, 0); PG8_STAGE(PG8_SA(0, 1), a2 + hstep, voffA);
            PG8_WAIT_V(8); PG8_WAIT_L(0); PG8_BAR; PG8_MMA(0, 0, At, B0); PG8_MMA(0, 1, At, B1); PG8_BAR; PG8_SCHED;
            PG8_LDA(At, 1, 1); PG8_STAGE(PG8_SB(1, 0), b3, voffB); PG8_STAGE(PG8_SB(1, 1), b3 + hstep, voffB); PG8_STAGE(PG8_SA(1, 0), a3, voffA);
            PG8_WAIT_V(8); PG8_WAIT_L(0); PG8_BAR; PG8_MMA(1, 0, At, B0); PG8_MMA(1, 1, At, B1); PG8_BAR; PG8_SCHED;
            } else {
            PG8_LDB(B0, 0, 0); PG8_SCHED; PG8_LDA(At, 0, 0); PG8_STAGE(PG8_SA(1, 1), a1 + hstep, voffA);
            PG8_WAIT_L(8); PG8_BAR; PG8_WAIT_L(0); PG8_MMA(0, 0, At, B0); PG8_BAR; PG8_SCHED;
            PG8_LDB(B1, 0, 1); PG8_STAGE(PG8_SB(0, 0), b2, voffB);
            PG8_BAR; PG8_WAIT_L(0); PG8_MMA(0, 1, At, B1); PG8_BAR;
            PG8_LDA(At, 0, 1); PG8_STAGE(PG8_SA(0, 0), a2, voffA);
            PG8_BAR; PG8_WAIT_L(0); PG8_MMA(1, 0, At, B0); PG8_BAR; PG8_SCHED;
            PG8_STAGE(PG8_SB(0, 1), b2 + hstep, voffB);
            PG8_WAIT_V(6); PG8_BAR; PG8_MMA(1, 1, At, B1); PG8_BAR;
            PG8_LDB(B0, 1, 0); PG8_SCHED; PG8_LDA(At, 1, 0); PG8_STAGE(PG8_SA(0, 1), a2 + hstep, voffA);
            PG8_WAIT_L(8); PG8_BAR; PG8_WAIT_L(0); PG8_MMA(0, 0, At, B0); PG8_BAR; PG8_SCHED;
            PG8_LDB(B1, 1, 1); PG8_STAGE(PG8_SB(1, 0), b3, voffB);
            PG8_BAR; PG8_WAIT_L(0); PG8_MMA(0, 1, At, B1); PG8_BAR;
            PG8_LDA(At, 1, 1); PG8_STAGE(PG8_SA(1, 0), a3, voffA);
            PG8_BAR; PG8_WAIT_L(0); PG8_MMA(1, 0, At, B0); PG8_BAR; PG8_SCHED;
            PG8_STAGE(PG8_SB(1, 1), b3 + hstep, voffB);
            PG8_WAIT_V(6); PG8_BAR; PG8_MMA(1, 1, At, B1); PG8_BAR;
            }
        }
        if constexpr (ALIGN_EPI) { if (wr == 0) PG8_BAR; }
        if constexpr (!Epi::AFTER_DRAIN) { E(acc, cur, wr, wc, fr, fq); S.done(cur); }
        if (!has_next) break;
#pragma unroll
        for (int a = 0; a < 2; ++a)
#pragma unroll
            for (int b = 0; b < 2; ++b)
#pragma unroll
                for (int m = 0; m < 4; ++m)
#pragma unroll
                    for (int n = 0; n < 2; ++n) acc[a][b][m][n] = (f32x4){0.f, 0.f, 0.f, 0.f};
        cur = nxt; cA = nA; cB = nB; ++ui;
        if constexpr (ALIGN_EPI) { if (wr == 1) PG8_BAR; }
    }
    PG8_WAIT_V(0);
    if constexpr (!ALIGN_EPI) { if (wr == 0) PG8_BAR; }
    PG8_BAR;
    if constexpr (Epi::AFTER_DRAIN) { E.fused(acc, cur, wr, wc, fr, fq, lds, wid, lane); S.done(cur); }
#undef PG8_SA
#undef PG8_SB
#undef PG8_STAGE
#undef PG8_LDA
#undef PG8_LDB
#undef PG8_MMA
#undef PG8_WAIT_V
#undef PG8_WAIT_L
#undef PG8_BAR
#undef PG8_SCHED
}
}

namespace sg {
using pg8::bf16_t; using pg8::bf16x8; using pg8::f32x4; using pg8::u32x4; using pg8::ssq_t;
typedef unsigned u32x2 __attribute__((ext_vector_type(2)));
constexpr int SROW0 = 32768;
template <bool GLU> __device__ __forceinline__ int brow(int tn, int ni) {
    if (GLU) { if (tn < 16) return 256 * (tn >> 2) + 32 * (tn & 3) + (ni & 1) * 16 + (ni >> 1) * 128; return 1024 + 64 * (tn - 16) + 16 * ni; }
    return 64 * tn + 16 * ni;
}
template <bool GLU, int KS, int MI, class SE>
__device__ __forceinline__ void small_gemm(PG8_LAS unsigned char* lds, const bf16_t* A, const bf16_t* Bt, int N, int K, const SE& E, int rb = 0, int re = 1 << 20) {
    int tid_ = threadIdx.x; asm volatile("" : "+v"(tid_));
    const int tid = tid_, wid = __builtin_amdgcn_readfirstlane(tid >> 6), lane = tid & 63, fr = lane & 15, fq = lane >> 4;
    constexpr int NTM = 512 / (16 * MI), RW = 2 * MI;
    const int klen = K >> 3, kbase = wid * klen, ntn = N / 64;
    const bool xm = (gridDim.x & 7) == 0;
    const int x = xm ? (blockIdx.x & 7) : 0, slot = xm ? (blockIdx.x >> 3) : blockIdx.x, nslots = xm ? (gridDim.x >> 3) : gridDim.x, tnx = xm ? (ntn >> 3) : ntn;
    for (int rnd = rb, j = slot + rb * nslots; rnd < re && j < tnx * NTM; ++rnd, j += nslots) {
        const int tn = x * tnx + j / NTM, tm = j % NTM;
        f32x4 acc[MI][4];
#pragma unroll
        for (int mi = 0; mi < MI; ++mi)
#pragma unroll
            for (int ni = 0; ni < 4; ++ni) acc[mi][ni] = (f32x4){0.f, 0.f, 0.f, 0.f};
        const bool act = (lane >> 3) < RW; const int erow = RW * wid + (lane >> 3), ej = lane & 7;
        typename SE::Pre pre = typename SE::Pre(); if (act) pre = E.pre(SROW0 + 16 * MI * tm + erow, tn, ej);
        const bf16_t* ap = A + (size_t)(SROW0 + 16 * MI * tm + fr) * K + kbase + 8 * fq;
        const bf16_t* bp[4];
#pragma unroll
        for (int ni = 0; ni < 4; ++ni) bp[ni] = Bt + (size_t)(brow<GLU>(tn, ni) + fr) * K + kbase + 8 * fq;
        for (int kc = 0; kc < klen; kc += 32 * KS) {
            bf16x8 a[KS][MI], b[KS][4];
#pragma unroll
            for (int s = 0; s < KS; ++s) {
#pragma unroll
                for (int mi = 0; mi < MI; ++mi) a[s][mi] = *(const bf16x8*)(ap + (size_t)mi * 16 * K + kc + 32 * s);
#pragma unroll
                for (int ni = 0; ni < 4; ++ni) b[s][ni] = *(const bf16x8*)(bp[ni] + kc + 32 * s);
            }
            __builtin_amdgcn_sched_barrier(0);
#pragma unroll
            for (int s = 0; s < KS; ++s)
#pragma unroll
                for (int mi = 0; mi < MI; ++mi)
#pragma unroll
                    for (int ni = 0; ni < 4; ++ni) acc[mi][ni] = __builtin_amdgcn_mfma_f32_16x16x32_bf16(b[s][ni], a[s][mi], acc[mi][ni], 0, 0, 0);
            __builtin_amdgcn_sched_barrier(0);
        }
        PG8_LAS unsigned char* mine = lds + wid * 16384;
#pragma unroll
        for (int mi = 0; mi < MI; ++mi)
#pragma unroll
            for (int ni = 0; ni < 4; ++ni) { const int row = 16 * mi + fr, ch = 4 * ni + fq; *(PG8_LAS f32x4*)(mine + row * 256 + ((ch ^ (row & 15)) << 4)) = acc[mi][ni]; }
        __syncthreads();
        if (act) {
            const int row = erow, j8 = ej;
            const bool glu = GLU && tn < 16;
            const int c0 = glu ? j8 : 2 * j8, c1 = glu ? 8 + j8 : 2 * j8 + 1;
            f32x4 v0 = (f32x4){0.f, 0.f, 0.f, 0.f}, v1 = v0;
#pragma unroll
            for (int p = 0; p < 8; ++p) { v0 += *(const PG8_LAS f32x4*)(lds + p * 16384 + row * 256 + ((c0 ^ (row & 15)) << 4)); v1 += *(const PG8_LAS f32x4*)(lds + p * 16384 + row * 256 + ((c1 ^ (row & 15)) << 4)); }
            E(SROW0 + 16 * MI * tm + row, tn, j8, v0, v1, pre);
        }
        __syncthreads();
    }
    asm volatile("s_waitcnt vmcnt(0)" ::: "memory");
    __syncthreads();
}
using pg8::sumsq8; using pg8::unpack8;
__device__ __forceinline__ float red8(float s) { s += __shfl_xor(s, 1); s += __shfl_xor(s, 2); s += __shfl_xor(s, 4); return s; }
struct SGlu { bf16_t* C; bf16_t* U; const ssq_t* ssq; typedef ssq_t Pre;
    __device__ __forceinline__ Pre pre(int r, int, int) const { return ssq[r]; }
    __device__ __forceinline__ void operator()(int r, int tn, int j, const f32x4 v0, const f32x4 v1, const Pre& p) const { const float rsv = pg8::rs_from(p);
        if (tn < 16) { const int ch0 = 128 * (tn >> 2) + 32 * (tn & 3) + 4 * j; float c[4];
#pragma unroll
            for (int i = 0; i < 4; ++i) c[i] = (v0[i] * rsv) * pg8::sigm(v1[i] * rsv);
            u32x2 w; w.x = pg8::cvt_pk_bf16(c[0], c[1]); w.y = pg8::cvt_pk_bf16(c[2], c[3]); *(u32x2*)(C + (size_t)r * 512 + ch0) = w; }
        else *(u32x4*)(U + (size_t)r * 512 + 64 * (tn - 16) + 8 * j) = pg8::pack8(v0 * rsv, v1 * rsv); } };
struct SRes { const bf16_t* base; bf16_t* XB; ssq_t* ssq_out; typedef u32x4 Pre;
    __device__ __forceinline__ Pre pre(int r, int tn, int j) const { return *(const u32x4*)(base + (size_t)r * 1024 + 64 * tn + 8 * j); }
    __device__ __forceinline__ void operator()(int r, int tn, int j, const f32x4 v0, const f32x4 v1, const Pre& p) const { const size_t off = (size_t)r * 1024 + 64 * tn + 8 * j;
        f32x4 b0, b1; unpack8(p, b0, b1); const u32x4 w = pg8::pack8(b0 + v0, b1 + v1); *(u32x4*)(XB + off) = w; unpack8(w, b0, b1);
        const float ss = red8(sumsq8(b0, b1)); if (j == 0) pg8::ssq_add(ssq_out + r, ss); } };
struct SRelu2 { bf16_t* H; const ssq_t* ssq; typedef ssq_t Pre;
    __device__ __forceinline__ Pre pre(int r, int, int) const { return ssq[r]; }
    __device__ __forceinline__ void operator()(int r, int tn, int j, f32x4 v0, f32x4 v1, const Pre& p) const { const float rsv = pg8::rs_from(p); v0 = v0 * rsv; v1 = v1 * rsv;
#pragma unroll
        for (int i = 0; i < 4; ++i) { v0[i] = fmaxf(v0[i], 0.f); v1[i] = fmaxf(v1[i], 0.f); }
        *(u32x4*)(H + (size_t)r * 4096 + 64 * tn + 8 * j) = pg8::pack8(v0 * v0, v1 * v1); } };
struct SQ { bf16_t* Q; typedef int Pre;
    __device__ __forceinline__ Pre pre(int, int, int) const { return 0; }
    __device__ __forceinline__ void operator()(int r, int tn, int j, const f32x4 v0, const f32x4 v1, const Pre&) const { *(u32x4*)(Q + (size_t)r * 1024 + 64 * tn + 8 * j) = pg8::pack8(v0, v1); } };
struct SGate { const bf16_t* Q; const bf16_t* XBin; bf16_t* XBout; const ssq_t* ssq; ssq_t* ssq_out;
    struct Pre { u32x4 q, x; ssq_t s; };
    __device__ __forceinline__ Pre pre(int r, int tn, int j) const { const size_t off = (size_t)r * 1024 + 64 * tn + 8 * j; Pre p; p.q = *(const u32x4*)(Q + off); p.x = *(const u32x4*)(XBin + off); p.s = ssq[r]; return p; }
    __device__ __forceinline__ void operator()(int r, int tn, int j, const f32x4 v0, const f32x4 v1, const Pre& p) const { const float rsv = pg8::rs_from(p.s); const size_t off = (size_t)r * 1024 + 64 * tn + 8 * j;
        f32x4 q0, q1, x0, x1; unpack8(p.q, q0, q1); unpack8(p.x, x0, x1);
        f32x4 o0, o1;
#pragma unroll
        for (int i = 0; i < 4; ++i) { o0[i] = x0[i] + pg8::sigm(v0[i] * rsv) * q0[i]; o1[i] = x1[i] + pg8::sigm(v1[i] * rsv) * q1[i]; }
        const u32x4 w = pg8::pack8(o0, o1); *(u32x4*)(XBout + off) = w; unpack8(w, o0, o1);
        const float ss = red8(sumsq8(o0, o1)); if (j == 0) pg8::ssq_add(ssq_out + r, ss); } };
}

constexpr int NWAVES = 8, NTHR = 512;
constexpr int DM = 1024, MP = 32768, MS = 512, MT = MP + MS, DEPTH = 4, DCONV = 512, DPOOL = 512, NIN = 1536, DFF = 4096, PLE = 256, SEQ = 4096, DSEQ = 64, NB = 8, CW = 31, HC = 30, HP = 15, PAST = 2048;
static_assert(MP == pg8::E_MP, "prompt rows");
constexpr size_t MiB = 1u << 20;
constexpr size_t WS_CTL = 0, CTL_ZERO_BYTES = 65536;
constexpr size_t WS_HIST = 1 * MiB;
constexpr size_t WS_SSQ = 3 * MiB;
constexpr size_t WS_W = 7 * MiB;
constexpr size_t WL_IN = 0, WL_OUT = 3 * MiB, WL_FF1 = 5 * MiB, WL_FF2 = 13 * MiB, WL_GATE = 21 * MiB, WL_PLE = 23 * MiB, WL_STRIDE = 23 * MiB + MiB / 2;
constexpr size_t WS_XB = 101 * MiB;
constexpr size_t WS_PB = 166 * MiB;
constexpr size_t WS_R = 231 * MiB;
constexpr size_t R_C = 0, R_U = (size_t)MT * 512 * 2, R_MIX = 2 * R_U, R_Q = R_MIX + (size_t)MT * 1024 * 2, R_XA = R_Q + (size_t)MT * 1024 * 2;
constexpr size_t WS_END = WS_R + (size_t)MT * 4096 * 2;
constexpr size_t H_CH = 0, H_UH = (size_t)4 * 8 * 30 * 512 * 2;
static_assert(WS_HIST + H_UH + (size_t)4 * 8 * 15 * 512 * 2 <= WS_SSQ && WS_SSQ + (size_t)13 * MT * 8 <= WS_W && WS_W + DEPTH * WL_STRIDE <= WS_XB && WS_XB + (size_t)MT * 2048 <= WS_PB && WS_PB + (size_t)DEPTH * MT * 512 <= WS_R && R_XA + (size_t)MT * 2048 <= (size_t)MT * 8192 && WS_END <= 512 * MiB, "d_ws map");
constexpr size_t OUT_Y = 0, OUT_NCP = (size_t)MT * DM, OUT_NPP = OUT_NCP + (size_t)DEPTH * NB * HC * DCONV, OUT_NCS = OUT_NPP + (size_t)DEPTH * NB * HP * DPOOL, OUT_NPS = OUT_NCS + (size_t)DEPTH * NB * HC * DCONV, OUT_END = OUT_NPS + (size_t)DEPTH * NB * HP * DPOOL;
constexpr int LDS_BYTES = 147456;
constexpr int MISC_OFF = 131072 + 320;

#define LAS __attribute__((address_space(3)))
typedef unsigned short bf16;
typedef unsigned v4u __attribute__((ext_vector_type(4)));
typedef unsigned v2u __attribute__((ext_vector_type(2)));
typedef float f32x4 __attribute__((ext_vector_type(4)));
#define LDS_WAIT() asm volatile("s_waitcnt lgkmcnt(0)" ::: "memory")
__device__ __forceinline__ unsigned pk2(float lo, float hi) { return pg8::cvt_pk_bf16(lo, hi); }
__device__ __forceinline__ float bf_lo(unsigned w) { return __uint_as_float(w << 16); }
__device__ __forceinline__ float bf_hi(unsigned w) { return __uint_as_float(w & 0xffff0000u); }
__device__ __forceinline__ float wave_sum(float v) {
#pragma unroll
    for (int o = 1; o < 64; o <<= 1) v += __shfl_xor(v, o);
    return v;
}

struct Args { const float* in[22]; float* out; unsigned char* ws; };
enum { I_XP = 0, I_XS, I_PP, I_PS, I_CC, I_CP, I_WIN, I_CONVW, I_CONVB, I_LNG, I_LNB, I_POOLW, I_PSCALE, I_WOUT, I_GMIX, I_GFFN, I_GPLE, I_WFF1, I_WFF2, I_WPLE, I_WGATE, I_GFINAL };

struct TrDesc { const float* W; const float* g; bf16* WT; int ldw, k0, n0, ldd, drow0; };
__device__ __forceinline__ void tr_load(const TrDesc& d, float (&v)[32], int lane) {
#pragma unroll
    for (int i = 0; i < 32; ++i) v[i] = d.W[(size_t)(d.k0 + 2 * i + (lane >> 5)) * d.ldw + d.n0 + (lane & 31)];
}
__device__ __forceinline__ void tr_store(const TrDesc& d, const float (&v)[32], LAS float* scr, int lane) {
#pragma unroll
    for (int i = 0; i < 32; ++i) scr[(2 * i + (lane >> 5)) * 33 + (lane & 31)] = v[i];
    const int c = lane & 7;
    f32x4 g0 = (f32x4){1.f, 1.f, 1.f, 1.f}, g1 = g0;
    if (d.g) { g0 = *(const f32x4*)(d.g + d.k0 + 8 * c); g1 = *(const f32x4*)(d.g + d.k0 + 8 * c + 4); }
    LDS_WAIT(); asm volatile("" ::: "memory");
#pragma unroll
    for (int j = 0; j < 4; ++j) { const int n = (lane >> 3) + 8 * j; const LAS float* s = scr + (8 * c) * 33 + n;
        v4u o; o.x = pk2(s[0 * 33] * g0[0], s[1 * 33] * g0[1]); o.y = pk2(s[2 * 33] * g0[2], s[3 * 33] * g0[3]); o.z = pk2(s[4 * 33] * g1[0], s[5 * 33] * g1[1]); o.w = pk2(s[6 * 33] * g1[2], s[7 * 33] * g1[3]);
        *(v4u*)(d.WT + (size_t)(d.drow0 + n) * d.ldd + d.k0 + 8 * c) = o; }
    LDS_WAIT(); asm volatile("" ::: "memory");
}
__device__ __forceinline__ int win_row(int n) { return n < 512 ? ((n >> 7) * 256 + (n & 127)) : (n < 1024 ? (((n - 512) >> 7) * 256 + 128 + (n & 127)) : n); }

__device__ __forceinline__ void prologue(const Args& a, LAS unsigned char* lds) {
    int tid_ = threadIdx.x; asm volatile("" : "+v"(tid_));
    const int tid = tid_, lane = tid & 63, wave = __builtin_amdgcn_readfirstlane(tid >> 6);
    const int G = gridDim.x, gw = blockIdx.x * NWAVES + wave, NGW = G * NWAVES;
    const size_t gt = (size_t)blockIdx.x * NTHR + tid, NGT = (size_t)G * NTHR;
    unsigned char* ws = a.ws;
    LAS float* scr = (LAS float*)(lds + wave * 16384);
    constexpr int IT_IN = 16 * 48, IT_OUT = 8 * 32, IT_FF1 = 16 * 128, IT_FF2 = 64 * 32, IT_GATE = 16 * 32, IT_PLE = 4 * 32, IT_L = IT_IN + IT_OUT + IT_FF1 + IT_FF2 + IT_GATE + IT_PLE;
#ifndef REP_T
#define REP_T 1
#endif
#ifndef REP_X
#define REP_X 1
#endif
    auto desc = [&](int it) -> TrDesc {
        const int l = it / IT_L; int r = it - l * IT_L; unsigned char* wl = ws + WS_W + (size_t)l * WL_STRIDE; TrDesc d;
        if (r < IT_IN) { const int kb = r / 48, nb = r % 48; d = TrDesc{a.in[I_WIN] + (size_t)l * DM * NIN, a.in[I_GMIX] + l * DM, (bf16*)(wl + WL_IN), NIN, 64 * kb, 32 * nb, DM, win_row(32 * nb)}; return d; } r -= IT_IN;
        if (r < IT_OUT) { const int kb = r / 32, nb = r % 32; d = TrDesc{a.in[I_WOUT] + (size_t)l * DM * DM, nullptr, (bf16*)(wl + WL_OUT), DM, 64 * kb, 32 * nb, DM, 32 * nb}; return d; } r -= IT_OUT;
        if (r < IT_FF1) { const int kb = r / 128, nb = r % 128; d = TrDesc{a.in[I_WFF1] + (size_t)l * DM * DFF, a.in[I_GFFN] + l * DM, (bf16*)(wl + WL_FF1), DFF, 64 * kb, 32 * nb, DM, 32 * nb}; return d; } r -= IT_FF1;
        if (r < IT_FF2) { const int kb = r / 32, nb = r % 32; d = TrDesc{a.in[I_WFF2] + (size_t)l * DFF * DM, nullptr, (bf16*)(wl + WL_FF2), DM, 64 * kb, 32 * nb, DFF, 32 * nb}; return d; } r -= IT_FF2;
        if (r < IT_GATE) { const int kb = r / 32, nb = r % 32; d = TrDesc{a.in[I_WGATE] + (size_t)l * DM * DM, a.in[I_GPLE] + l * DM, (bf16*)(wl + WL_GATE), DM, 64 * kb, 32 * nb, DM, 32 * nb}; return d; } r -= IT_GATE;
        { const int kb = r / 32, nb = r % 32; d = TrDesc{a.in[I_WPLE] + (size_t)l * PLE * DM, nullptr, (bf16*)(wl + WL_PLE), DM, 64 * kb, 32 * nb, PLE, 32 * nb}; return d; }
    };
    for (int rep = 0; rep < REP_T; ++rep)
    for (int it = gw; it < DEPTH * IT_L; it += 2 * NGW) {
        const bool two = it + NGW < DEPTH * IT_L;
        const TrDesc dA = desc(it), dB = desc(two ? it + NGW : it);
        float vA[32], vB[32];
        tr_load(dA, vA, lane); if (two) tr_load(dB, vB, lane);
        tr_store(dA, vA, scr, lane); if (two) tr_store(dB, vB, scr, lane);
    }
    for (size_t w = gt; w < (size_t)DEPTH * 4 * 16 * 256; w += NGT) {
        const int n4 = (int)(w & 255); const int hi = __builtin_amdgcn_readfirstlane((int)(w >> 8)); const int cb = hi & 15, g = (hi >> 4) & 3, l = hi >> 6;
        const float* wo = a.in[I_WOUT] + (size_t)l * DM * DM + (size_t)(512 + 128 * g) * DM + 4 * n4; const float* sc = a.in[I_PSCALE] + l * DPOOL + 128 * g;
        const float* pw = a.in[I_POOLW] + ((size_t)(l * 4 + g) * 128 + 8 * cb) * 128;
        f32x4 acc[8];
#pragma unroll
        for (int j = 0; j < 8; ++j) acc[j] = (f32x4){0.f, 0.f, 0.f, 0.f};
#pragma unroll 8
        for (int d = 0; d < 128; ++d) { const f32x4 wv = *(const f32x4*)(wo + (size_t)d * DM) * sc[d];
#pragma unroll
            for (int j = 0; j < 8; ++j) acc[j] += wv * pw[j * 128 + d]; }
        bf16* dst = (bf16*)(ws + WS_W + (size_t)l * WL_STRIDE + WL_OUT) + (size_t)(4 * n4) * DM + 512 + 128 * g + 8 * cb;
#pragma unroll
        for (int i = 0; i < 4; ++i) { v4u o; o.x = pk2(acc[0][i], acc[1][i]); o.y = pk2(acc[2][i], acc[3][i]); o.z = pk2(acc[4][i], acc[5][i]); o.w = pk2(acc[6][i], acc[7][i]); *(v4u*)(dst + (size_t)i * DM) = o; }
    }
    for (int rep = 0; rep < REP_X; ++rep) {
    pg8::ssq_t* ssq = (pg8::ssq_t*)(ws + WS_SSQ);
    for (int r0 = gw; r0 < MT; r0 += 2 * NGW) {
        f32x4 v[2][4];
#pragma unroll
        for (int u = 0; u < 2; ++u) { const int r = r0 + u * NGW; if (r < MT) { const float* xr = (r < MP) ? a.in[I_XP] + (size_t)r * DM : a.in[I_XS] + (size_t)(r - MP) * DM;
#pragma unroll
            for (int j = 0; j < 4; ++j) v[u][j] = *((const f32x4*)xr + lane + 64 * j); } }
#pragma unroll
        for (int u = 0; u < 2; ++u) { const int r = r0 + u * NGW; if (r < MT) { bf16* o = (bf16*)(ws + WS_R + R_XA) + (size_t)r * DM; float s = 0.f;
#pragma unroll
            for (int j = 0; j < 4; ++j) { const f32x4 t = v[u][j]; s += (t[0] * t[0] + t[1] * t[1]) + (t[2] * t[2] + t[3] * t[3]);
                v2u p; p.x = pk2(t[0], t[1]); p.y = pk2(t[2], t[3]); *((v2u*)o + lane + 64 * j) = p; }
            s = wave_sum(s); if (lane == 0) ssq[r] = (pg8::ssq_t)(s * 1048576.0f); } }
    }
    for (size_t i = gt; i < (size_t)12 * MT; i += NGT) ssq[MT + i] = 0ull;
    for (size_t i = gt; i < (size_t)DEPTH * NB * (HC + HP) * 256; i += NGT) {
        const size_t nc = (size_t)DEPTH * NB * HC * 256;
        if (i < nc) { const float* s = a.in[I_CC] + 2 * i; *((unsigned*)(ws + WS_HIST + H_CH) + i) = pk2(s[0], s[1]); }
        else { const size_t k = i - nc; const float* s = a.in[I_CP] + 2 * k; *((unsigned*)(ws + WS_HIST + H_UH) + k) = pk2(s[0], s[1]); }
    }
    constexpr size_t NPI = (size_t)DEPTH * MT * (PLE / 8);
    for (size_t i0 = gt; i0 < NPI; i0 += 4 * NGT) {
        f32x4 v0[4], v1[4];
#pragma unroll
        for (int u = 0; u < 4; ++u) { const size_t i = i0 + u * NGT; if (i < NPI) {
            const int c8 = (int)(i & 31); const size_t lr = i >> 5; const int l = (int)(lr / MT), r = (int)(lr % MT);
            const float* src = (r < MP) ? a.in[I_PP] + ((size_t)l * MP + r) * PLE : a.in[I_PS] + ((size_t)l * MS + (r - MP)) * PLE;
            v0[u] = *((const f32x4*)src + 2 * c8); v1[u] = *((const f32x4*)src + 2 * c8 + 1); } }
#pragma unroll
        for (int u = 0; u < 4; ++u) { const size_t i = i0 + u * NGT; if (i < NPI) {
            v4u o; o.x = pk2(v0[u][0], v0[u][1]); o.y = pk2(v0[u][2], v0[u][3]); o.z = pk2(v1[u][0], v1[u][1]); o.w = pk2(v1[u][2], v1[u][3]);
            *((v4u*)(ws + WS_PB) + i) = o; } }
    }
    }
}

typedef float f32x2 __attribute__((ext_vector_type(2)));
template <int CTRL> __device__ __forceinline__ float dpp_mov(float v) { return __builtin_bit_cast(float, __builtin_amdgcn_update_dpp(0, __builtin_bit_cast(int, v), CTRL, 0xF, 0xF, true)); }
__device__ __forceinline__ float row16_sum(float v) {
    v += dpp_mov<0xB1>(v); v += dpp_mov<0x4E>(v); v += dpp_mov<0x141>(v); v += dpp_mov<0x140>(v); return v;
}
template <int W, int R> __device__ __forceinline__ void pool_load(unsigned (&pk)[31], const bf16* U, const bf16* hist, bool samp, int seqbase, int tb, int cp) {
#pragma unroll
    for (int j = 0; j < W + R - 1; ++j) { const int t = tb - (W - 1) + j;
        const bf16* src = t >= 0 ? U + (size_t)(seqbase + t) * 512 : (samp ? hist + (size_t)(HP + t) * DPOOL : U);
        pk[j] = *(const unsigned*)(src + 2 * cp); }
}
template <int W, int R> __device__ __forceinline__ void pool_rows(const unsigned (&pk)[31], bool samp, int tb, int pos0, bf16* mixrow) {
    f32x2 a[W + R - 1];
#pragma unroll
    for (int j = 0; j < W + R - 1; ++j) { const int t = tb - (W - 1) + j; const bool valid = (t >= 0) || samp; a[j] = valid ? (f32x2){bf_lo(pk[j]), bf_hi(pk[j])} : (f32x2){0.f, 0.f}; }
    f32x2 s = (f32x2){0.f, 0.f};
#pragma unroll
    for (int k = 0; k < W; ++k) s += a[k];
#pragma unroll
    for (int i = 0; i < R; ++i) {
        if (i > 0) { if (W >= 8) { s += a[i + W - 1]; s -= a[i - 1]; }
                     else { s = (f32x2){0.f, 0.f};
#pragma unroll
                            for (int k = 0; k < W; ++k) s += a[i + k]; } }
        const int pos = pos0 + tb + i; const float inv = 1.0f / (float)(pos + 1 < W ? pos + 1 : W);
        *(unsigned*)(mixrow + (size_t)i * 1024) = pk2(s.x * inv - a[i + W - 1].x, s.y * inv - a[i + W - 1].y); }
}
template <int R> __device__ __forceinline__ void pb_item(int r0, bool samp, int l, const bf16* C, const bf16* U, bf16* MIX, const unsigned char* ws, const LAS f32x2* wl, f32x2 cb, f32x2 lg, f32x2 lb,
                                                         LAS f32x2* red, LAS f32x2* st, int tid, int lane, int half, int wq, int cp) {
    int b, t0, seqbase; if (!samp) { b = r0 >> 12; t0 = r0 & 4095; seqbase = b << 12; } else { const int rr = r0 - MP; b = rr >> 6; t0 = rr & 63; seqbase = MP + (b << 6); }
    const int tb = t0 + R * half, pos0 = samp ? PAST : 0;
    const bf16* chist = (const bf16*)(ws + WS_HIST + H_CH) + (size_t)(l * NB + b) * HC * DCONV;
    const bf16* uhist = (const bf16*)(ws + WS_HIST + H_UH) + (size_t)(l * NB + b) * HP * DPOOL;
    unsigned pk[R + 30];
#pragma unroll
    for (int j = 0; j < R + 30; ++j) { const int t = tb - HC + j;
        const bf16* src = t >= 0 ? C + (size_t)(seqbase + t) * 512 : (samp ? chist + (size_t)(HC + t) * DCONV : C);
        pk[j] = *(const unsigned*)(src + 2 * cp); }
    unsigned pp[31];
    if (wq == 0) pool_load<2, R>(pp, U, uhist, samp, seqbase, tb, cp); else if (wq == 1) pool_load<4, R>(pp, U, uhist, samp, seqbase, tb, cp);
    else if (wq == 2) pool_load<8, R>(pp, U, uhist, samp, seqbase, tb, cp); else pool_load<16, R>(pp, U, uhist, samp, seqbase, tb, cp);
    f32x2 o[R];
    { f32x2 w[CW];
#pragma unroll
      for (int k = 0; k < CW; ++k) w[k] = wl[k * 256 + cp];
#pragma unroll
      for (int i = 0; i < R; ++i) o[i] = cb;
#pragma unroll
      for (int j = 0; j < R + 30; ++j) { const int t = tb - HC + j; const bool valid = (t >= 0) || samp;
          const f32x2 v = valid ? (f32x2){bf_lo(pk[j]), bf_hi(pk[j])} : (f32x2){0.f, 0.f};
#pragma unroll
          for (int i = 0; i < R; ++i) { const int k = j - i; if (k >= 0 && k < CW) o[i] += w[k] * v; } } }
#pragma unroll
    for (int i = 0; i < R; ++i) { const float s = row16_sum(o[i].x + o[i].y), q = row16_sum(o[i].x * o[i].x + o[i].y * o[i].y);
        if ((lane & 15) == 0) red[(half * R + i) * 16 + wq * 4 + (lane >> 4)] = (f32x2){s, q}; }
    __syncthreads();
    if (tid < 2 * R) { float s = 0.f, q = 0.f;
#pragma unroll
        for (int k = 0; k < 16; ++k) { const f32x2 p = red[tid * 16 + k]; s += p.x; q += p.y; }
        const float mean = s * (1.0f / DCONV), var = q * (1.0f / DCONV) - mean * mean; st[tid] = (f32x2){mean, rsqrtf(fmaxf(var, 0.f) + 1e-6f)}; }
    __syncthreads();
    bf16* mrow = MIX + (size_t)(r0 + R * half) * 1024 + 2 * cp;
#pragma unroll
    for (int i = 0; i < R; ++i) { const f32x2 ms = st[half * R + i];
        float y0 = (o[i].x - ms.x) * ms.y * lg.x + lb.x, y1 = (o[i].y - ms.x) * ms.y * lg.y + lb.y; y0 *= pg8::sigm(y0); y1 *= pg8::sigm(y1);
        *(unsigned*)(mrow + (size_t)i * 1024) = pk2(y0, y1); }
    bf16* prow = mrow + 512;
    if (wq == 0) pool_rows<2, R>(pp, samp, tb, pos0, prow); else if (wq == 1) pool_rows<4, R>(pp, samp, tb, pos0, prow);
    else if (wq == 2) pool_rows<8, R>(pp, samp, tb, pos0, prow); else pool_rows<16, R>(pp, samp, tb, pos0, prow);
}

__device__ __forceinline__ void phase_b(const Args& a, int l, LAS unsigned char* lds) {
    int tid_ = threadIdx.x; asm volatile("" : "+v"(tid_));
    const int tid = tid_, lane = tid & 63, wave = __builtin_amdgcn_readfirstlane(tid >> 6), half = wave >> 2, wq = wave & 3, cp = wq * 64 + lane;
    unsigned char* ws = a.ws;
    const bf16* C = (const bf16*)(ws + WS_R + R_C); const bf16* U = (const bf16*)(ws + WS_R + R_U); bf16* MIX = (bf16*)(ws + WS_R + R_MIX);
    LAS f32x2* red = (LAS f32x2*)lds;
    LAS f32x2* st = (LAS f32x2*)(lds + 4096);
    LAS f32x2* wl = (LAS f32x2*)(lds + 8192);
    { const f32x2* cw = (const f32x2*)(a.in[I_CONVW] + (size_t)l * CW * DCONV);
      for (int i = tid; i < CW * 256; i += NTHR) wl[i] = cw[i];
      __syncthreads(); }
    const f32x2 cb = *(const f32x2*)(a.in[I_CONVB] + l * DCONV + 2 * cp), lg = *(const f32x2*)(a.in[I_LNG] + l * DCONV + 2 * cp), lb = *(const f32x2*)(a.in[I_LNB] + l * DCONV + 2 * cp);
    for (int ib = blockIdx.x; ib < MP / 32; ib += gridDim.x) pb_item<16>(ib * 32, false, l, C, U, MIX, ws, wl, cb, lg, lb, red, st, tid, lane, half, wq, cp);
    for (int jb = blockIdx.x; jb < MS / 2; jb += gridDim.x) pb_item<1>(MP + jb * 2, true, l, C, U, MIX, ws, wl, cb, lg, lb, red, st, tid, lane, half, wq, cp);
    const size_t gt = (size_t)blockIdx.x * NTHR + tid, NGT = (size_t)gridDim.x * NTHR;
    constexpr int NC = NB * HC * DCONV, NPL = NB * HP * DPOOL;
    for (size_t i = gt; i < (size_t)2 * (NC + NPL); i += NGT) { int r = (int)i; float* out = a.out;
        if (r < NC) { const int ch = r & 511, j = (r >> 9) % HC, b = (r >> 9) / HC; out[OUT_NCP + (size_t)l * NC + r] = bf_lo(C[((size_t)b * SEQ + SEQ - HC + j) * 512 + ch]); continue; } r -= NC;
        if (r < NPL) { const int ch = r & 511, j = (r >> 9) % HP, b = (r >> 9) / HP; out[OUT_NPP + (size_t)l * NPL + r] = bf_lo(U[((size_t)b * SEQ + SEQ - HP + j) * 512 + ch]); continue; } r -= NPL;
        if (r < NC) { const int ch = r & 511, j = (r >> 9) % HC, b = (r >> 9) / HC; out[OUT_NCS + (size_t)l * NC + r] = bf_lo(C[((size_t)MP + b * DSEQ + DSEQ - HC + j) * 512 + ch]); continue; } r -= NC;
        { const int ch = r & 511, j = (r >> 9) % HP, b = (r >> 9) / HP; out[OUT_NPS + (size_t)l * NPL + r] = bf_lo(U[((size_t)MP + b * DSEQ + DSEQ - HP + j) * 512 + ch]); }
    }
}

#define XB_TMO      128
#define XB_XCNT(j)  (256  + 64 * (j))
#define XB_XSUB(j)  (1280 + 64 * (j))
#define XB_XGEN(j)  (2304 + 64 * (j))
#define XB_TOP      3328
#define XB_TOPGEN   3392
#define XCD_BAR_WORDS 3456
#define XB_SPIN_CAP (1u << 18)

__device__ __forceinline__ unsigned xb_ld(unsigned* p)              { return __hip_atomic_load(p, __ATOMIC_RELAXED, __HIP_MEMORY_SCOPE_AGENT); }
__device__ __forceinline__ unsigned xb_add(unsigned* p, unsigned v) { return __hip_atomic_fetch_add(p, v, __ATOMIC_RELAXED, __HIP_MEMORY_SCOPE_AGENT); }
__device__ __forceinline__ unsigned xb_xcc_id() { return (unsigned)__builtin_amdgcn_s_getreg((3 << 11) | 20) & 0xFu; }
#define XB_SPIN(cond, bar) do { unsigned _sp = 0; while (cond) { __builtin_amdgcn_s_sleep(1); \
    if ((++_sp & 255u) == 0u) { if (xb_ld(&(bar)[XB_TMO])) break; if (_sp > XB_SPIN_CAP) { atomicAdd(&(bar)[XB_TMO], 1u); break; } } } } while (0)

struct XcdBarrier {
    unsigned* bar; unsigned x;
    volatile LAS unsigned* st;
};

__device__ __forceinline__ XcdBarrier xcd_barrier_post(unsigned* bar, volatile LAS unsigned* st) {
    XcdBarrier b; b.bar = bar; b.x = xb_xcc_id(); b.st = st;
    if (threadIdx.x == 0) (void)xb_add(&bar[XB_XCNT(b.x)], 1u);
    return b;
}
__device__ __forceinline__ void xcd_barrier_complete(unsigned* bar, unsigned x, unsigned& nloc, unsigned& nx) {
    const unsigned G = gridDim.x * gridDim.y * gridDim.z;
    unsigned sum, cnt, mine, sp = 0u;
    for (;;) {
        sum = 0u; cnt = 0u; mine = 0u;
#pragma unroll
        for (unsigned j = 0; j < 16; ++j) { const unsigned c = xb_ld(&bar[XB_XCNT(j)]); sum += c; cnt += (c > 0u) ? 1u : 0u; mine = (j == x) ? c : mine; }
        if (sum == G) break;
        __builtin_amdgcn_s_sleep(1);
        if ((++sp & 255u) == 0u) { if (xb_ld(&bar[XB_TMO])) break; if (sp > XB_SPIN_CAP) { atomicAdd(&bar[XB_TMO], 1u); break; } }
    }
    nloc = mine > 0u ? mine : 1u; nx = cnt > 0u ? cnt : 1u;
}

__device__ __forceinline__ void xcd_barrier(const XcdBarrier& b) {
    asm volatile("s_waitcnt vmcnt(0)" ::: "memory");
    __syncthreads();
    if (threadIdx.x == 0) {
        unsigned* bar = b.bar;
        __builtin_amdgcn_s_waitcnt(0);
        unsigned nloc = b.st[0], nx = b.st[1];
        if (nloc == 0u) { xcd_barrier_complete(bar, b.x, nloc, nx); b.st[0] = nloc; b.st[1] = nx; }
        const unsigned old = xb_add(&bar[XB_XSUB(b.x)], 1u);
        const unsigned gen = old / nloc;
        if (old + 1u == (gen + 1u) * nloc) {
            __builtin_amdgcn_fence(__ATOMIC_RELEASE, "agent");
            asm volatile("s_waitcnt vmcnt(0)" ::: "memory");
            const unsigned og = xb_add(&bar[XB_TOP], 1u);
            const unsigned tg = og / nx;
            if (og + 1u == (tg + 1u) * nx) xb_add(&bar[XB_TOPGEN], 1u);
            else XB_SPIN(xb_ld(&bar[XB_TOPGEN]) == tg, bar);
            __builtin_amdgcn_fence(__ATOMIC_ACQUIRE, "agent");
            xb_add(&bar[XB_XGEN(b.x)], 1u);
            asm volatile("s_waitcnt vmcnt(0)" ::: "memory");
        } else {
            XB_SPIN(xb_ld(&bar[XB_XGEN(b.x)]) == gen, bar);
            __builtin_amdgcn_fence(__ATOMIC_ACQUIRE, "agent");
            asm volatile("s_waitcnt vmcnt(0)" ::: "memory");
        }
    }
    __syncthreads();
}

__global__ void __launch_bounds__(NTHR, 2) mk_fwd(Args a) {
    extern __shared__ __attribute__((aligned(16))) unsigned char lds_raw[];
    LAS unsigned char* lds = (LAS unsigned char*)lds_raw;
    cg::grid_group grid = cg::this_grid();
    volatile LAS unsigned* MISC = (volatile LAS unsigned*)(lds + MISC_OFF);
    if (threadIdx.x < 32) MISC[threadIdx.x] = 0u;
    __syncthreads();
    const XcdBarrier bar = xcd_barrier_post((unsigned*)(a.ws + WS_CTL), MISC + 8);
#define GRID_BAR() xcd_barrier(bar)
    unsigned char* ws = a.ws;
    pg8::ssq_t* ssq = (pg8::ssq_t*)(ws + WS_SSQ); float* X = a.out;
    bf16* XB = (bf16*)(ws + WS_XB); bf16* XA = (bf16*)(ws + WS_R + R_XA);
    bf16* Cb = (bf16*)(ws + WS_R + R_C); bf16* Ub = (bf16*)(ws + WS_R + R_U); bf16* MIX = (bf16*)(ws + WS_R + R_MIX); bf16* Qb = (bf16*)(ws + WS_R + R_Q); bf16* Hb = (bf16*)(ws + WS_R);
    const int G = gridDim.x, c = blockIdx.x;
#ifndef REP_B
#define REP_B 1
#endif
#ifndef REP_D
#define REP_D 1
#endif
#ifndef REP_S
#define REP_S 1
#endif
    prologue(a, lds);
    asm volatile("s_waitcnt vmcnt(0) lgkmcnt(0)" ::: "memory"); __syncthreads();
    grid.sync();
    __builtin_amdgcn_fence(__ATOMIC_ACQUIRE, "agent"); asm volatile("s_waitcnt vmcnt(0)" ::: "memory"); __syncthreads();
    const int alt = c & 1, cls3 = (c & 7) % 3;
#pragma unroll 1
    for (int l = 0; l < DEPTH; ++l) {
        const unsigned char* wl = ws + WS_W + (size_t)l * WL_STRIDE;
#pragma unroll 1
        for (int st = 0; st < 2; ++st) {
            if ((st ^ alt) == 0) { pg8::Gemm g{XA, (const bf16*)(wl + WL_IN), MT, NIN, DM}; pg8::StaticOrder S; S.init(MP, NIN, G, c);
                pg8::EpiGLU E{Cb, Ub, ssq + (size_t)(3 * l) * MT};
                pg8::gemm_phase<pg8::EpiGLU, pg8::StaticOrder, true, true>(lds, g, S, E); }
            else { sg::SGlu SE{Cb, Ub, ssq + (size_t)(3 * l) * MT}; sg::small_gemm<true, 4, 4, sg::SGlu>(lds, XA, (const bf16*)(wl + WL_IN), NIN, DM, SE); } }
        GRID_BAR();
        phase_b(a, l, lds);
        GRID_BAR();
#pragma unroll 1
        for (int st = 0; st < 2; ++st) {
            if ((st ^ alt) == 0) { pg8::Gemm g{MIX, (const bf16*)(wl + WL_OUT), MT, DM, DM}; pg8::StaticOrder S; S.init(MP, DM, G, c);
                pg8::EpiRes E{XA, XB, ssq + (size_t)(3 * l + 1) * MT};
                pg8::gemm_phase<pg8::EpiRes, pg8::StaticOrder, true, true>(lds, g, S, E); }
            else { sg::SRes SE{XA, XB, ssq + (size_t)(3 * l + 1) * MT}; sg::small_gemm<false, 4, 2, sg::SRes>(lds, MIX, (const bf16*)(wl + WL_OUT), DM, DM, SE); } }
        GRID_BAR();
#pragma unroll 1
        for (int st = 0; st < 3; ++st) {
            if (st == 1) { pg8::Gemm g{XB, (const bf16*)(wl + WL_FF1), MT, DFF, DM}; pg8::StaticOrder S; S.init(MP, DFF, G, c);
                pg8::EpiRelu2 E{Hb, ssq + (size_t)(3 * l + 1) * MT};
                pg8::gemm_phase<pg8::EpiRelu2, pg8::StaticOrder, true, true>(lds, g, S, E); }
            else { sg::SRelu2 SE{Hb, ssq + (size_t)(3 * l + 1) * MT}; sg::small_gemm<false, 4, 4, sg::SRelu2>(lds, XB, (const bf16*)(wl + WL_FF1), DFF, DM, SE, st == 0 ? 0 : cls3, st == 0 ? cls3 : (1 << 20)); } }
        GRID_BAR();
#pragma unroll 1
        for (int st = 0; st < 2; ++st) {
            if ((st ^ alt) == 0) { pg8::Gemm g{Hb, (const bf16*)(wl + WL_FF2), MT, DM, DFF}; pg8::StaticOrder S; S.init(MP, DM, G, c);
                pg8::EpiRes E{XB, XB, ssq + (size_t)(3 * l + 2) * MT};
                pg8::gemm_phase<pg8::EpiRes, pg8::StaticOrder, true, true>(lds, g, S, E); }
            else { sg::SRes SE{XB, XB, ssq + (size_t)(3 * l + 2) * MT}; sg::small_gemm<false, 4, 2, sg::SRes>(lds, Hb, (const bf16*)(wl + WL_FF2), DM, DFF, SE); } }
        GRID_BAR();
#pragma unroll 1
        for (int st = 0; st < 4; ++st) { const int op = (st + 2 * alt) & 3;
            if (op == 0) { pg8::Gemm g{(const bf16*)(ws + WS_PB) + (size_t)l * MT * PLE, (const bf16*)(wl + WL_PLE), MT, DM, PLE}; pg8::StaticOrder S; S.init(MP, DM, G, c);
                pg8::EpiQ E{Qb};
                pg8::gemm_phase<pg8::EpiQ, pg8::StaticOrder, true, true>(lds, g, S, E); }
            else if (op == 1) { pg8::Gemm g{XB, (const bf16*)(wl + WL_GATE), MT, DM, DM}; pg8::StaticOrder S; S.init(MP, DM, G, c);
                pg8::EpiGate E{Qb, XB, XA, ssq + (size_t)(3 * l + 2) * MT, ssq + (size_t)(3 * l + 3) * MT};
                pg8::gemm_phase<pg8::EpiGate, pg8::StaticOrder, true, true>(lds, g, S, E); }
            else if (op == 2) { sg::SQ SE{Qb}; sg::small_gemm<false, 1, 2, sg::SQ>(lds, (const bf16*)(ws + WS_PB) + (size_t)l * MT * PLE, (const bf16*)(wl + WL_PLE), DM, PLE, SE); }
            else { sg::SGate SE{Qb, XB, XA, ssq + (size_t)(3 * l + 2) * MT, ssq + (size_t)(3 * l + 3) * MT}; sg::small_gemm<false, 4, 2, sg::SGate>(lds, XB, (const bf16*)(wl + WL_GATE), DM, DM, SE); } }
        GRID_BAR();
    }
    { const int lane = threadIdx.x & 63, gw = blockIdx.x * NWAVES + (threadIdx.x >> 6), NGW = G * NWAVES; const pg8::ssq_t* sq = ssq + (size_t)12 * MT; const float* gf = a.in[I_GFINAL];
      for (int r0 = gw; r0 < MT; r0 += 2 * NGW) {
          v4u xw[2][2]; float rsv[2];
#pragma unroll
          for (int u = 0; u < 2; ++u) { const int r = r0 + u * NGW; if (r < MT) { rsv[u] = pg8::rs_of(sq, r); const v4u* xr = (const v4u*)(XA + (size_t)r * DM); xw[u][0] = xr[lane]; xw[u][1] = xr[lane + 64]; } }
#pragma unroll
          for (int u = 0; u < 2; ++u) { const int r = r0 + u * NGW; if (r < MT) { f32x4* yr = (f32x4*)(X + (size_t)r * DM);
#pragma unroll
              for (int j = 0; j < 2; ++j) { f32x4 v0, v1; pg8::unpack8(xw[u][j], v0, v1); const f32x4 g0 = *((const f32x4*)gf + 2 * (lane + 64 * j)), g1 = *((const f32x4*)gf + 2 * (lane + 64 * j) + 1);
                  yr[2 * (lane + 64 * j)] = v0 * rsv[u] * g0; yr[2 * (lane + 64 * j) + 1] = v1 * rsv[u] * g1; } } } } }
}

extern "C" void kernel_launch(void* const* d_in, const int* in_sizes, int n_in, void* d_out, int out_size, void* d_ws, size_t ws_size, hipStream_t stream) {
    static int grid = 0;
    if (grid == 0) {
        if (n_in != 22 || in_sizes[0] != MP * DM || (size_t)out_size != OUT_END || ws_size < WS_END) { fprintf(stderr, "kernel_launch: unexpected shapes (n_in %d, in0 %d, out %d, ws %zu; need ws >= %zu); nothing launched\n", n_in, n_in > 0 ? in_sizes[0] : -1, out_size, ws_size, (size_t)WS_END); grid = -1; return; }
        int dev = 0, cus = 0, per_cu = 0;
        if (hipGetDevice(&dev) != hipSuccess || hipDeviceGetAttribute(&cus, hipDeviceAttributeMultiprocessorCount, dev) != hipSuccess) { grid = -1; return; }
        if (hipFuncSetAttribute((const void*)mk_fwd, hipFuncAttributeMaxDynamicSharedMemorySize, LDS_BYTES) != hipSuccess) { fprintf(stderr, "kernel_launch: hipFuncSetAttribute failed\n"); grid = -1; return; }
        if (hipOccupancyMaxActiveBlocksPerMultiprocessor(&per_cu, (const void*)mk_fwd, NTHR, LDS_BYTES) != hipSuccess || per_cu < 1) { fprintf(stderr, "kernel_launch: occupancy query says %d\n", per_cu); per_cu = 1; }
        (void)hipGetLastError();
        grid = cus;
    }
    if (grid < 0) return;
    (void)hipMemsetAsync((char*)d_ws + WS_CTL, 0, CTL_ZERO_BYTES, stream);
    Args a{};
    for (int i = 0; i < 22; ++i) a.in[i] = (const float*)d_in[i];
    a.out = (float*)d_out; a.ws = (unsigned char*)d_ws;
    void* args[] = {&a};
    hipError_t e = hipLaunchCooperativeKernel((const void*)mk_fwd, dim3(grid), dim3(NTHR), args, LDS_BYTES, stream);
    if (e != hipSuccess) fprintf(stderr, "kernel_launch: cooperative launch failed: %s (grid %d)\n", hipGetErrorString(e), grid);
}
```

```cpp
#include <hip/hip_runtime.h>
#include <hip/hip_cooperative_groups.h>
#include <cstdio>
#include <cstdint>
namespace cg = cooperative_groups;
namespace pg8 {
#define PG8_LAS __attribute__((address_space(3)))
typedef unsigned short bf16_t;
typedef short bf16x8 __attribute__((ext_vector_type(8)));
typedef float f32x4 __attribute__((ext_vector_type(4)));
typedef unsigned u32x4 __attribute__((ext_vector_type(4)));
constexpr int BM = 256, BK = 64, HALF = 128, HTB = HALF * BK * 2  , STAGE_BYTES = 8 * HTB, NXCD = 8, WGM = 8;

__host__ __device__ __forceinline__ int lds_byte(int r, int c) { const int st = (r >> 4) * 2 + (c >> 5), rr = r & 15, cc = c & 31, ob = rr * 64 + cc * 2; return st * 1024 + (ob ^ (((ob >> 9) & 1) << 5)); }
__host__ __device__ __forceinline__ void stage_rc(int b, int& R, int& C) { const int st = b / 1024, sb = b % 1024, swz = sb ^ (((sb >> 9) & 1) << 5); R = (st >> 1) * 16 + swz / 64; C = (st & 1) * 32 + (swz % 64) / 2; }
__host__ __device__ __forceinline__ int perm32(int rho) { const int n = rho >> 4, i = rho & 15; return 8 * (i >> 2) + 4 * n + (i & 3); }

struct Unit { int pm, pn; };
struct Gemm { const bf16_t* A; const bf16_t* Bt; int M, N, K; };

struct StaticOrder {
    int nM, nN, nwg, G, c;
    __host__ __device__ void init(int M, int N, int G_, int c_) { nM = M / BM; nN = N / BM; nwg = nM * nN; G = G_; c = c_; }
    __host__ __device__ bool next(int i, Unit& u) const {
        const long L = (long)i * G + c; if (L >= nwg) return false;
        int wgid = (int)L; { const int q = nwg / NXCD, r = nwg % NXCD, xcd = wgid % NXCD, off = wgid / NXCD; wgid = (xcd < r ? xcd * (q + 1) : r * (q + 1) + (xcd - r) * q) + off; }
        const int nig = WGM * nN, gid = wgid / nig, fm = gid * WGM, gsz = (nM - fm) < WGM ? (nM - fm) : WGM;
        u.pm = fm + ((wgid % nig) % gsz); u.pn = (wgid % nig) / gsz; return true;
    }
    __device__ __forceinline__ void a_ready(const Unit&) const {}
    __device__ __forceinline__ void done(const Unit&) const {}
};
constexpr int E_MP = 32768;
__device__ __forceinline__ unsigned cvt_pk_bf16(float lo, float hi) { unsigned r; asm volatile("v_cvt_pk_bf16_f32 %0, %1, %2" : "=v"(r) : "v"(lo), "v"(hi)); return r; }
__device__ __forceinline__ float sigm(float x) { return __builtin_amdgcn_rcpf(1.0f + __expf(-x)); }
__device__ __forceinline__ u32x4 pack8(const f32x4 v0, const f32x4 v1) { u32x4 w; w.x = cvt_pk_bf16(v0[0], v0[1]); w.y = cvt_pk_bf16(v0[2], v0[3]); w.z = cvt_pk_bf16(v1[0], v1[1]); w.w = cvt_pk_bf16(v1[2], v1[3]); return w; }
typedef unsigned long long ssq_t;
__device__ __forceinline__ float rs_of(const ssq_t* ssq, int r) { return rsqrtf((float)ssq[r] * (1.0f / (1024.0f * 1048576.0f)) + 1e-6f); }
__device__ __forceinline__ float rs_from(ssq_t v) { return rsqrtf((float)v * (1.0f / (1024.0f * 1048576.0f)) + 1e-6f); }
__device__ __forceinline__ void ssq_add(ssq_t* p, float ss) { atomicAdd(p, (ssq_t)(ss * 1048576.0f)); }

constexpr int RS_SLOTS = 8, RS_OFF = 131072 + 2048;
template <class Sched> __device__ __forceinline__ void rs_preload(PG8_LAS float* rsl, const ssq_t* ssq, const Sched& S, int tid) {
    if (tid < 256) { ssq_t v[RS_SLOTS]; Unit u;
#pragma unroll
        for (int i = 0; i < RS_SLOTS; ++i) v[i] = S.next(i, u) ? ssq[u.pm * BM + tid] : (ssq_t)0;
#pragma unroll
        for (int i = 0; i < RS_SLOTS; ++i) rsl[i * 256 + tid] = rs_from(v[i]); }
    __syncthreads();
}
struct EpiGLU {
    static constexpr bool PERM = true, AFTER_DRAIN = false;
    bf16_t* C; bf16_t* U; const ssq_t* ssq;
    __device__ __forceinline__ void operator()(const f32x4 (&acc)[2][2][4][2], const Unit& u, int wr, int wc, int fr0, int fq0) const {
        int fr = fr0, fq = fq0; asm volatile("" : "+v"(fr), "+v"(fq));
        const int row0 = u.pm * BM + wr * 64 + fr;
        if (u.pn < 4) {
            const int ch0 = u.pn * 128 + wc * 32 + 8 * fq;
#pragma unroll
            for (int ai = 0; ai < 2; ++ai)
#pragma unroll
                for (int m = 0; m < 4; ++m) { const int r = row0 + ai * HALF + m * 16; const float rsv = rs_of(ssq, r);
                    f32x4 c0, c1;
#pragma unroll
                    for (int j = 0; j < 4; ++j) { c0[j] = (acc[ai][0][m][0][j] * rsv) * sigm(acc[ai][1][m][0][j] * rsv); c1[j] = (acc[ai][0][m][1][j] * rsv) * sigm(acc[ai][1][m][1][j] * rsv); }
                    *(u32x4*)(C + (size_t)r * 512 + ch0) = pack8(c0, c1); }
        } else {
            const int uc0 = (u.pn - 4) * 256 + wc * 32 + 8 * fq;
#pragma unroll
            for (int ai = 0; ai < 2; ++ai)
#pragma unroll
                for (int m = 0; m < 4; ++m) { const int r = row0 + ai * HALF + m * 16; const float rsv = rs_of(ssq, r);
#pragma unroll
                    for (int bj = 0; bj < 2; ++bj) *(u32x4*)(U + (size_t)r * 512 + uc0 + bj * HALF) = pack8(acc[ai][bj][m][0] * rsv, acc[ai][bj][m][1] * rsv); }
        }
    }
};
__device__ __forceinline__ void unpack8(const u32x4 w, f32x4& a, f32x4& b) {
    a[0] = __uint_as_float(w.x << 16); a[1] = __uint_as_float(w.x & 0xffff0000u); a[2] = __uint_as_float(w.y << 16); a[3] = __uint_as_float(w.y & 0xffff0000u);
    b[0] = __uint_as_float(w.z << 16); b[1] = __uint_as_float(w.z & 0xffff0000u); b[2] = __uint_as_float(w.w << 16); b[3] = __uint_as_float(w.w & 0xffff0000u); }
__device__ __forceinline__ float sumsq8(const f32x4 a, const f32x4 b) { return (a[0] * a[0] + a[1] * a[1]) + (a[2] * a[2] + a[3] * a[3]) + (b[0] * b[0] + b[1] * b[1]) + (b[2] * b[2] + b[3] * b[3]); }
struct EpiRes {
    static constexpr bool PERM = true, AFTER_DRAIN = false;
    const bf16_t* base; bf16_t* XB; ssq_t* ssq_out;
    __device__ __forceinline__ void operator()(const f32x4 (&acc)[2][2][4][2], const Unit& u, int wr, int wc, int fr0, int fq0) const {
        int fr = fr0, fq = fq0; asm volatile("" : "+v"(fr), "+v"(fq));
        const int row0 = u.pm * BM + wr * 64 + fr, col0 = u.pn * BM + wc * 32 + 8 * fq;
        u32x4 bw[2][4][2];
#pragma unroll
        for (int m = 0; m < 4; ++m)
#pragma unroll
            for (int bj = 0; bj < 2; ++bj) bw[0][m][bj] = *(const u32x4*)(base + (size_t)(row0 + m * 16) * 1024 + col0 + bj * HALF);
#pragma unroll
        for (int m = 0; m < 2; ++m)
#pragma unroll
            for (int bj = 0; bj < 2; ++bj) bw[1][m][bj] = *(const u32x4*)(base + (size_t)(row0 + HALF + m * 16) * 1024 + col0 + bj * HALF);
        __builtin_amdgcn_sched_barrier(0);
#pragma unroll
        for (int ai = 0; ai < 2; ++ai) {
#pragma unroll
            for (int m = 0; m < 4; ++m) { const int r = row0 + ai * HALF + m * 16; float ss = 0.f;
#pragma unroll
                for (int bj = 0; bj < 2; ++bj) { const size_t off = (size_t)r * 1024 + col0 + bj * HALF;
                    f32x4 b0, b1; unpack8(bw[ai][m][bj], b0, b1);
                    const u32x4 w = pack8(b0 + acc[ai][bj][m][0], b1 + acc[ai][bj][m][1]); *(u32x4*)(XB + off) = w;
                    unpack8(w, b0, b1); ss += sumsq8(b0, b1); }
                ss += __shfl_xor(ss, 16); ss += __shfl_xor(ss, 32);
                if (fq == 0) ssq_add(ssq_out + r, ss);
                if (ai == 0 && m == 1) {
                    __builtin_amdgcn_sched_barrier(0);
#pragma unroll
                    for (int m2 = 2; m2 < 4; ++m2)
#pragma unroll
                        for (int bj = 0; bj < 2; ++bj) bw[1][m2][bj] = *(const u32x4*)(base + (size_t)(row0 + HALF + m2 * 16) * 1024 + col0 + bj * HALF);
                    __builtin_amdgcn_sched_barrier(0); } }
        }
        __builtin_amdgcn_sched_barrier(0);
    }
};
struct EpiRelu2 {
    static constexpr bool PERM = true, AFTER_DRAIN = false;
    bf16_t* H; const ssq_t* ssq; const PG8_LAS float* rsl; mutable int ui;
    __device__ __forceinline__ void operator()(const f32x4 (&acc)[2][2][4][2], const Unit& u, int wr, int wc, int fr0, int fq0) const {
        int fr = fr0, fq = fq0; asm volatile("" : "+v"(fr), "+v"(fq));
        const int row0 = u.pm * BM + wr * 64 + fr, col0 = u.pn * BM + wc * 32 + 8 * fq;
        const int slot = ui; ++ui;
#pragma unroll
        for (int ai = 0; ai < 2; ++ai)
#pragma unroll
            for (int m = 0; m < 4; ++m) { const int r = row0 + ai * HALF + m * 16; const float rsv = slot < RS_SLOTS ? rsl[slot * 256 + ai * HALF + wr * 64 + m * 16 + fr] : rs_of(ssq, r);
#pragma unroll
                for (int bj = 0; bj < 2; ++bj) { f32x4 v0 = acc[ai][bj][m][0] * rsv, v1 = acc[ai][bj][m][1] * rsv;
#pragma unroll
                    for (int j = 0; j < 4; ++j) { v0[j] = fmaxf(v0[j], 0.f); v1[j] = fmaxf(v1[j], 0.f); }
                    *(u32x4*)(H + (size_t)r * 4096 + col0 + bj * HALF) = pack8(v0 * v0, v1 * v1); } }
    }
};
struct EpiQ {
    static constexpr bool PERM = true, AFTER_DRAIN = false;
    bf16_t* Q;
    __device__ __forceinline__ void operator()(const f32x4 (&acc)[2][2][4][2], const Unit& u, int wr, int wc, int fr0, int fq0) const {
        int fr = fr0, fq = fq0; asm volatile("" : "+v"(fr), "+v"(fq));
        const int row0 = u.pm * BM + wr * 64 + fr, col0 = u.pn * BM + wc * 32 + 8 * fq;
#pragma unroll
        for (int ai = 0; ai < 2; ++ai)
#pragma unroll
            for (int m = 0; m < 4; ++m) { const int r = row0 + ai * HALF + m * 16;
#pragma unroll
                for (int bj = 0; bj < 2; ++bj) *(u32x4*)(Q + (size_t)r * 1024 + col0 + bj * HALF) = pack8(acc[ai][bj][m][0], acc[ai][bj][m][1]); }
    }
};
struct EpiGate {
    static constexpr bool PERM = true, AFTER_DRAIN = false;
    const bf16_t* Q; const bf16_t* XBin; bf16_t* XBout; const ssq_t* ssq; ssq_t* ssq_out;
    __device__ __forceinline__ void operator()(const f32x4 (&acc)[2][2][4][2], const Unit& u, int wr, int wc, int fr0, int fq0) const {
        int fr = fr0, fq = fq0; asm volatile("" : "+v"(fr), "+v"(fq));
        const int row0 = u.pm * BM + wr * 64 + fr, col0 = u.pn * BM + wc * 32 + 8 * fq;
#pragma unroll
        for (int ai = 0; ai < 2; ++ai) {
            u32x4 qw[4][2], xw[4][2]; ssq_t sq[4];
#pragma unroll
            for (int m = 0; m < 4; ++m) { sq[m] = ssq[row0 + ai * HALF + m * 16];
#pragma unroll
                for (int bj = 0; bj < 2; ++bj) { const size_t off = (size_t)(row0 + ai * HALF + m * 16) * 1024 + col0 + bj * HALF; qw[m][bj] = *(const u32x4*)(Q + off); xw[m][bj] = *(const u32x4*)(XBin + off); } }
            __builtin_amdgcn_sched_barrier(0);
#pragma unroll
            for (int m = 0; m < 4; ++m) { const int r = row0 + ai * HALF + m * 16; const float rsv = rsqrtf((float)sq[m] * (1.0f / (1024.0f * 1048576.0f)) + 1e-6f); float ss = 0.f;
#pragma unroll
                for (int bj = 0; bj < 2; ++bj) { const size_t off = (size_t)r * 1024 + col0 + bj * HALF;
                    f32x4 q0, q1, x0, x1; unpack8(qw[m][bj], q0, q1); unpack8(xw[m][bj], x0, x1);
                    f32x4 o0, o1;
#pragma unroll
                    for (int j = 0; j < 4; ++j) { o0[j] = x0[j] + sigm(acc[ai][bj][m][0][j] * rsv) * q0[j]; o1[j] = x1[j] + sigm(acc[ai][bj][m][1][j] * rsv) * q1[j]; }
                    const u32x4 w = pack8(o0, o1); *(u32x4*)(XBout + off) = w;
                    unpack8(w, o0, o1); ss += sumsq8(o0, o1); }
                ss += __shfl_xor(ss, 16); ss += __shfl_xor(ss, 32);
                if (fq == 0) ssq_add(ssq_out + r, ss); }
            __builtin_amdgcn_sched_barrier(0);
        }
    }
};
template <class Epi, class Sched, bool ALIGN_EPI = false, bool SP2 = false>
__device__ __forceinline__ void gemm_phase(PG8_LAS unsigned char* lds, const Gemm g, const Sched& S, const Epi& E) {
    int tid_ = threadIdx.x; asm volatile("" : "+v"(tid_));
    const int tid = tid_, wid = __builtin_amdgcn_readfirstlane(tid >> 6), lane = tid & 63, wr = wid >> 2, wc = wid & 3, fr = lane & 15, fq = lane >> 4;
    int K_ = g.K; asm volatile("" : "+s"(K_));
    const int K = K_, nt = K / BK;
    unsigned voffA[2], voffB[2];
#pragma unroll
    for (int i = 0; i < 2; ++i) { int R, C; stage_rc(tid * 16 + i * 8192, R, C); const int Rb = Epi::PERM ? ((R & ~31) + perm32(R & 31)) : R;
        voffA[i] = (unsigned)(R * K + C) * 2u; voffB[i] = (unsigned)(Rb * K + C) * 2u; }
    const size_t kstep = (size_t)(BK * 2);
    const size_t hstep = (size_t)HALF * K * 2;
    const size_t tstep = 2 * hstep;
    const unsigned ldsw = (unsigned)wid * 1024u;
    const int aoff = lds_byte(wr * 64 + fr, fq * 8), boff = lds_byte(wc * 32 + fr, fq * 8);
#define PG8_SA(b, h) (((b) * 2 + (h)) * HTB)
#define PG8_SB(b, h) ((4 + (b) * 2 + (h)) * HTB)
#define PG8_STAGE(bufoff, gbase, voff) do { _Pragma("unroll") for (int _i = 0; _i < 2; ++_i) \
        __builtin_amdgcn_global_load_lds((const unsigned*)((const char*)(gbase) + (voff)[_i]), (PG8_LAS unsigned*)(lds + (bufoff) + ldsw + _i * 8192), 16, 0, 0); } while (0)
#define PG8_LDA(dst, b, h) do { _Pragma("unroll") for (int m = 0; m < 4; ++m) _Pragma("unroll") for (int k = 0; k < 2; ++k) dst[m][k] = *(const PG8_LAS bf16x8*)(lds + PG8_SA(b, h) + aoff + m * 2048 + k * 1024); } while (0)
#define PG8_LDB(dst, b, h) do { _Pragma("unroll") for (int n = 0; n < 2; ++n) _Pragma("unroll") for (int k = 0; k < 2; ++k) dst[n][k] = *(const PG8_LAS bf16x8*)(lds + PG8_SB(b, h) + boff + n * 2048 + k * 1024); } while (0)
#define PG8_MMA(ai, bj, At, Bt) do { __builtin_amdgcn_s_setprio(1); _Pragma("unroll") for (int m = 0; m < 4; ++m) _Pragma("unroll") for (int n = 0; n < 2; ++n) _Pragma("unroll") for (int k = 0; k < 2; ++k) \
        acc[ai][bj][m][n] = __builtin_amdgcn_mfma_f32_16x16x32_bf16(Bt[n][k], At[m][k], acc[ai][bj][m][n], 0, 0, 0); __builtin_amdgcn_s_setprio(0); } while (0)
#define PG8_WAIT_V(n) asm volatile("s_waitcnt vmcnt(" #n ")" ::: "memory")
#define PG8_WAIT_L(n) asm volatile("s_waitcnt lgkmcnt(" #n ")" ::: "memory")
#define PG8_BAR __builtin_amdgcn_s_barrier()
#define PG8_SCHED __builtin_amdgcn_sched_barrier(0)
    Unit cur, nxt; int ui = 0;
    if (!S.next(0, cur)) return;
    f32x4 acc[2][2][4][2];
#pragma unroll
    for (int a = 0; a < 2; ++a)
#pragma unroll
        for (int b = 0; b < 2; ++b)
#pragma unroll
            for (int m = 0; m < 4; ++m)
#pragma unroll
                for (int n = 0; n < 2; ++n) acc[a][b][m][n] = (f32x4){0.f, 0.f, 0.f, 0.f};
    bf16x8 At[4][2], B0[2][2], B1[2][2];
    const char* cA = (const char*)g.A + (size_t)cur.pm * tstep; const char* cB = (const char*)g.Bt + (size_t)cur.pn * tstep;
    S.a_ready(cur);
    if constexpr (SP2) {
        PG8_STAGE(PG8_SB(0, 0), cB, voffB); PG8_STAGE(PG8_SB(0, 1), cB + hstep, voffB); PG8_STAGE(PG8_SA(0, 0), cA, voffA); PG8_STAGE(PG8_SA(0, 1), cA + hstep, voffA);
        if (wr == 1) PG8_BAR;
        PG8_WAIT_V(2); PG8_BAR;
        PG8_STAGE(PG8_SB(1, 0), cB + kstep, voffB); PG8_STAGE(PG8_SA(1, 0), cA + kstep, voffA); PG8_STAGE(PG8_SB(1, 1), cB + hstep + kstep, voffB);
        PG8_WAIT_V(6); PG8_BAR;
    } else {
        PG8_STAGE(PG8_SB(0, 0), cB, voffB); PG8_STAGE(PG8_SA(0, 0), cA, voffA); PG8_STAGE(PG8_SB(0, 1), cB + hstep, voffB); PG8_STAGE(PG8_SA(0, 1), cA + hstep, voffA);
        if (wr == 1) PG8_BAR;
        PG8_WAIT_V(4); PG8_BAR;
        PG8_STAGE(PG8_SB(1, 0), cB + kstep, voffB); PG8_STAGE(PG8_SA(1, 0), cA + kstep, voffA); PG8_STAGE(PG8_SB(1, 1), cB + hstep + kstep, voffB);
        PG8_WAIT_V(6); PG8_BAR;
    }
    for (;;) {
        const bool has_next = S.next(ui + 1, nxt);
        const char* nA = has_next ? (const char*)g.A + (size_t)nxt.pm * tstep : cA; const char* nB = has_next ? (const char*)g.Bt + (size_t)nxt.pn * tstep : cB;
        for (int t = 0; t < nt; t += 2) {
            const bool last = (t == nt - 2);
            const char* a1 = cA + (size_t)(t + 1) * kstep;
            const char* a2 = last ? nA : cA + (size_t)(t + 2) * kstep; const char* b2 = last ? nB : cB + (size_t)(t + 2) * kstep;
            const char* a3 = a2 + kstep; const char* b3 = b2 + kstep;
            if (last && has_next) S.a_ready(nxt);
            if constexpr (SP2) {
            PG8_LDB(B0, 0, 0); PG8_LDB(B1, 0, 1); PG8_SCHED; PG8_LDA(At, 0, 0); PG8_STAGE(PG8_SA(1, 1), a1 + hstep, voffA);
            PG8_WAIT_V(8); PG8_WAIT_L(0); PG8_BAR; PG8_MMA(0, 0, At, B0); PG8_MMA(0, 1, At, B1); PG8_BAR; PG8_SCHED;
            PG8_LDA(At, 0, 1); PG8_STAGE(PG8_SB(0, 0), b2, voffB); PG8_STAGE(PG8_SB(0, 1), b2 + hstep, voffB); PG8_STAGE(PG8_SA(0, 0), a2, voffA);
            PG8_WAIT_V(8); PG8_WAIT_L(0); PG8_BAR; PG8_MMA(1, 0, At, B0); PG8_MMA(1, 1, At, B1); PG8_BAR; PG8_SCHED;
            PG8_LDB(B0, 1, 0); PG8_LDB(B1, 1, 1); PG8_SCHED; PG8_LDA(At, 1, 0); PG8_STAGE(PG8_SA(0, 1), a2 + hstep, voffA);
            PG8_WAIT_V(8); PG8_WAIT_L(0); PG8_BAR; PG8_MMA(0, 0, At, B0); PG8_MMA(0, 1, At, B1); PG8_BAR; PG8_SCHED;
            PG8_LDA(At, 1, 1); PG8_STAGE(PG8_SB(1, 0), b3, voffB); PG8_STAGE(PG8_SB(1, 1), b3 + hstep, voffB); PG8_STAGE(PG8_SA(1, 0), a3, voffA);
            PG8_WAIT_V(8); PG8_WAIT_L(0); PG8_BAR; PG8_MMA(1, 0, At, B0); PG8_MMA(1, 1, At, B1); PG8_BAR; PG8_SCHED;
            } else {
            PG8_LDB(B0, 0, 0); PG8_SCHED; PG8_LDA(At, 0, 0); PG8_STAGE(PG8_SA(1, 1), a1 + hstep, voffA);
            PG8_WAIT_L(8); PG8_BAR; PG8_WAIT_L(0); PG8_MMA(0, 0, At, B0); PG8_BAR; PG8_SCHED;
            PG8_LDB(B1, 0, 1); PG8_STAGE(PG8_SB(0, 0), b2, voffB);
            PG8_BAR; PG8_WAIT_L(0); PG8_MMA(0, 1, At, B1); PG8_BAR;
            PG8_LDA(At, 0, 1); PG8_STAGE(PG8_SA(0, 0), a2, voffA);
            PG8_BAR; PG8_WAIT_L(0); PG8_MMA(1, 0, At, B0); PG8_BAR; PG8_SCHED;
            PG8_STAGE(PG8_SB(0, 1), b2 + hstep, voffB);
            PG8_WAIT_V(6); PG8_BAR; PG8_MMA(1, 1, At, B1); PG8_BAR;
            PG8_LDB(B0, 1, 0); PG8_SCHED; PG8_LDA(At, 1, 0); PG8_STAGE(PG8_SA(0, 1), a2 + hstep, voffA);
            PG8_WAIT_L(8); PG8_BAR; PG8_WAIT_L(0); PG8_MMA(0, 0, At, B0); PG8_BAR; PG8_SCHED;
            PG8_LDB(B1, 1, 1); PG8_STAGE(PG8_SB(1, 0), b3, voffB);
            PG8_BAR; PG8_WAIT_L(0); PG8_MMA(0, 1, At, B1); PG8_BAR;
            PG8_LDA(At, 1, 1); PG8_STAGE(PG8_SA(1, 0), a3, voffA);
            PG8_BAR; PG8_WAIT_L(0); PG8_MMA(1, 0, At, B0); PG8_BAR; PG8_SCHED;
            PG8_STAGE(PG8_SB(1, 1), b3 + hstep, voffB);
            PG8_WAIT_V(6); PG8_BAR; PG8_MMA(1, 1, At, B1); PG8_BAR;
            }
        }
        if constexpr (ALIGN_EPI) { if (wr == 0) PG8_BAR; }
        if constexpr (!Epi::AFTER_DRAIN) { E(acc, cur, wr, wc, fr, fq); S.done(cur); }
        if (!has_next) break;
#pragma unroll
        for (int a = 0; a < 2; ++a)
#pragma unroll
            for (int b = 0; b < 2; ++b)
#pragma unroll
                for (int m = 0; m < 4; ++m)
#pragma unroll
                    for (int n = 0; n < 2; ++n) acc[a][b][m][n] = (f32x4){0.f, 0.f, 0.f, 0.f};
        cur = nxt; cA = nA; cB = nB; ++ui;
        if constexpr (ALIGN_EPI) { if (wr == 1) PG8_BAR; }
    }
    PG8_WAIT_V(0);
    if constexpr (!ALIGN_EPI) { if (wr == 0) PG8_BAR; }
    PG8_BAR;
    if constexpr (Epi::AFTER_DRAIN) { E.fused(acc, cur, wr, wc, fr, fq, lds, wid, lane); S.done(cur); }
#undef PG8_SA
#undef PG8_SB
#undef PG8_STAGE
#undef PG8_LDA
#undef PG8_LDB
#undef PG8_MMA
#undef PG8_WAIT_V
#undef PG8_WAIT_L
#undef PG8_BAR
#undef PG8_SCHED
}
}

namespace sg {
using pg8::bf16_t; using pg8::bf16x8; using pg8::f32x4; using pg8::u32x4; using pg8::ssq_t;
typedef unsigned u32x2 __attribute__((ext_vector_type(2)));
constexpr int SROW0 = 32768;
template <bool GLU> __device__ __forceinline__ int brow(int tn, int ni) {
    if (GLU) { if (tn < 16) return 256 * (tn >> 2) + 32 * (tn & 3) + (ni & 1) * 16 + (ni >> 1) * 128; return 1024 + 64 * (tn - 16) + 16 * ni; }
    return 64 * tn + 16 * ni;
}
template <bool GLU, int KS, int MI, class SE>
__device__ __forceinline__ void small_gemm(PG8_LAS unsigned char* lds, const bf16_t* A, const bf16_t* Bt, int N, int K, const SE& E) {
    int tid_ = threadIdx.x; asm volatile("" : "+v"(tid_));
    const int tid = tid_, wid = __builtin_amdgcn_readfirstlane(tid >> 6), lane = tid & 63, fr = lane & 15, fq = lane >> 4;
    constexpr int NTM = 512 / (16 * MI), RW = 2 * MI;
    const int klen = K >> 3, kbase = wid * klen, ntn = N / 64;
    const bool xm = (gridDim.x & 7) == 0;
    const int x = xm ? (blockIdx.x & 7) : 0, slot = xm ? (blockIdx.x >> 3) : blockIdx.x, nslots = xm ? (gridDim.x >> 3) : gridDim.x, tnx = xm ? (ntn >> 3) : ntn;
    for (int j = slot; j < tnx * NTM; j += nslots) {
        const int tn = x * tnx + j / NTM, tm = j % NTM;
        f32x4 acc[MI][4];
#pragma unroll
        for (int mi = 0; mi < MI; ++mi)
#pragma unroll
            for (int ni = 0; ni < 4; ++ni) acc[mi][ni] = (f32x4){0.f, 0.f, 0.f, 0.f};
        const bool act = (lane >> 3) < RW; const int erow = RW * wid + (lane >> 3), ej = lane & 7;
        typename SE::Pre pre = typename SE::Pre(); if (act) pre = E.pre(SROW0 + 16 * MI * tm + erow, tn, ej);
        const bf16_t* ap = A + (size_t)(SROW0 + 16 * MI * tm + fr) * K + kbase + 8 * fq;
        const bf16_t* bp[4];
#pragma unroll
        for (int ni = 0; ni < 4; ++ni) bp[ni] = Bt + (size_t)(brow<GLU>(tn, ni) + fr) * K + kbase + 8 * fq;
        for (int kc = 0; kc < klen; kc += 32 * KS) {
            bf16x8 a[KS][MI], b[KS][4];
#pragma unroll
            for (int s = 0; s < KS; ++s) {
#pragma unroll
                for (int mi = 0; mi < MI; ++mi) a[s][mi] = *(const bf16x8*)(ap + (size_t)mi * 16 * K + kc + 32 * s);
#pragma unroll
                for (int ni = 0; ni < 4; ++ni) b[s][ni] = *(const bf16x8*)(bp[ni] + kc + 32 * s);
            }
            __builtin_amdgcn_sched_barrier(0);
#pragma unroll
            for (int s = 0; s < KS; ++s)
#pragma unroll
                for (int mi = 0; mi < MI; ++mi)
#pragma unroll
                    for (int ni = 0; ni < 4; ++ni) acc[mi][ni] = __builtin_amdgcn_mfma_f32_16x16x32_bf16(b[s][ni], a[s][mi], acc[mi][ni], 0, 0, 0);
            __builtin_amdgcn_sched_barrier(0);
        }
        PG8_LAS unsigned char* mine = lds + wid * 16384;
#pragma unroll
        for (int mi = 0; mi < MI; ++mi)
#pragma unroll
            for (int ni = 0; ni < 4; ++ni) { const int row = 16 * mi + fr, ch = 4 * ni + fq; *(PG8_LAS f32x4*)(mine + row * 256 + ((ch ^ (row & 15)) << 4)) = acc[mi][ni]; }
        __syncthreads();
        if (act) {
            const int row = erow, j8 = ej;
            const bool glu = GLU && tn < 16;
            const int c0 = glu ? j8 : 2 * j8, c1 = glu ? 8 + j8 : 2 * j8 + 1;
            f32x4 v0 = (f32x4){0.f, 0.f, 0.f, 0.f}, v1 = v0;
#pragma unroll
            for (int p = 0; p < 8; ++p) { v0 += *(const PG8_LAS f32x4*)(lds + p * 16384 + row * 256 + ((c0 ^ (row & 15)) << 4)); v1 += *(const PG8_LAS f32x4*)(lds + p * 16384 + row * 256 + ((c1 ^ (row & 15)) << 4)); }
            E(SROW0 + 16 * MI * tm + row, tn, j8, v0, v1, pre);
        }
        __syncthreads();
    }
    asm volatile("s_waitcnt vmcnt(0)" ::: "memory");
    __syncthreads();
}
using pg8::sumsq8; using pg8::unpack8;
__device__ __forceinline__ float red8(float s) { s += __shfl_xor(s, 1); s += __shfl_xor(s, 2); s += __shfl_xor(s, 4); return s; }
struct SGlu { bf16_t* C; bf16_t* U; const ssq_t* ssq; typedef ssq_t Pre;
    __device__ __forceinline__ Pre pre(int r, int, int) const { return ssq[r]; }
    __device__ __forceinline__ void operator()(int r, int tn, int j, const f32x4 v0, const f32x4 v1, const Pre& p) const { const float rsv = pg8::rs_from(p);
        if (tn < 16) { const int ch0 = 128 * (tn >> 2) + 32 * (tn & 3) + 4 * j; float c[4];
#pragma unroll
            for (int i = 0; i < 4; ++i) c[i] = (v0[i] * rsv) * pg8::sigm(v1[i] * rsv);
            u32x2 w; w.x = pg8::cvt_pk_bf16(c[0], c[1]); w.y = pg8::cvt_pk_bf16(c[2], c[3]); *(u32x2*)(C + (size_t)r * 512 + ch0) = w; }
        else *(u32x4*)(U + (size_t)r * 512 + 64 * (tn - 16) + 8 * j) = pg8::pack8(v0 * rsv, v1 * rsv); } };
struct SRes { const bf16_t* base; bf16_t* XB; ssq_t* ssq_out; typedef u32x4 Pre;
    __device__ __forceinline__ Pre pre(int r, int tn, int j) const { return *(const u32x4*)(base + (size_t)r * 1024 + 64 * tn + 8 * j); }
    __device__ __forceinline__ void operator()(int r, int tn, int j, const f32x4 v0, const f32x4 v1, const Pre& p) const { const size_t off = (size_t)r * 1024 + 64 * tn + 8 * j;
        f32x4 b0, b1; unpack8(p, b0, b1); const u32x4 w = pg8::pack8(b0 + v0, b1 + v1); *(u32x4*)(XB + off) = w; unpack8(w, b0, b1);
        const float ss = red8(sumsq8(b0, b1)); if (j == 0) pg8::ssq_add(ssq_out + r, ss); } };
struct SRelu2 { bf16_t* H; const ssq_t* ssq; typedef ssq_t Pre;
    __device__ __forceinline__ Pre pre(int r, int, int) const { return ssq[r]; }
    __device__ __forceinline__ void operator()(int r, int tn, int j, f32x4 v0, f32x4 v1, const Pre& p) const { const float rsv = pg8::rs_from(p); v0 = v0 * rsv; v1 = v1 * rsv;
#pragma unroll
        for (int i = 0; i < 4; ++i) { v0[i] = fmaxf(v0[i], 0.f); v1[i] = fmaxf(v1[i], 0.f); }
        *(u32x4*)(H + (size_t)r * 4096 + 64 * tn + 8 * j) = pg8::pack8(v0 * v0, v1 * v1); } };
struct SQ { bf16_t* Q; typedef int Pre;
    __device__ __forceinline__ Pre pre(int, int, int) const { return 0; }
    __device__ __forceinline__ void operator()(int r, int tn, int j, const f32x4 v0, const f32x4 v1, const Pre&) const { *(u32x4*)(Q + (size_t)r * 1024 + 64 * tn + 8 * j) = pg8::pack8(v0, v1); } };
struct SGate { const bf16_t* Q; const bf16_t* XBin; bf16_t* XBout; const ssq_t* ssq; ssq_t* ssq_out;
    struct Pre { u32x4 q, x; ssq_t s; };
    __device__ __forceinline__ Pre pre(int r, int tn, int j) const { const size_t off = (size_t)r * 1024 + 64 * tn + 8 * j; Pre p; p.q = *(const u32x4*)(Q + off); p.x = *(const u32x4*)(XBin + off); p.s = ssq[r]; return p; }
    __device__ __forceinline__ void operator()(int r, int tn, int j, const f32x4 v0, const f32x4 v1, const Pre& p) const { const float rsv = pg8::rs_from(p.s); const size_t off = (size_t)r * 1024 + 64 * tn + 8 * j;
        f32x4 q0, q1, x0, x1; unpack8(p.q, q0, q1); unpack8(p.x, x0, x1);
        f32x4 o0, o1;
#pragma unroll
        for (int i = 0; i < 4; ++i) { o0[i] = x0[i] + pg8::sigm(v0[i] * rsv) * q0[i]; o1[i] = x1[i] + pg8::sigm(v1[i] * rsv) * q1[i]; }
        const u32x4 w = pg8::pack8(o0, o1); *(u32x4*)(XBout + off) = w; unpack8(w, o0, o1);
        const float ss = red8(sumsq8(o0, o1)); if (j == 0) pg8::ssq_add(ssq_out + r, ss); } };
}

constexpr int NWAVES = 8, NTHR = 512;
constexpr int DM = 1024, MP = 32768, MS = 512, MT = MP + MS, DEPTH = 4, DCONV = 512, DPOOL = 512, NIN = 1536, DFF = 4096, PLE = 256, SEQ = 4096, DSEQ = 64, NB = 8, CW = 31, HC = 30, HP = 15, PAST = 2048;
static_assert(MP == pg8::E_MP, "prompt rows");
constexpr size_t MiB = 1u << 20;
constexpr size_t WS_CTL = 0, CTL_ZERO_BYTES = 65536;
constexpr size_t WS_HIST = 1 * MiB;
constexpr size_t WS_SSQ = 3 * MiB;
constexpr size_t WS_W = 7 * MiB;
constexpr size_t WL_IN = 0, WL_OUT = 3 * MiB, WL_FF1 = 5 * MiB, WL_FF2 = 13 * MiB, WL_GATE = 21 * MiB, WL_PLE = 23 * MiB, WL_STRIDE = 23 * MiB + MiB / 2;
constexpr size_t WS_XB = 101 * MiB;
constexpr size_t WS_PB = 166 * MiB;
constexpr size_t WS_R = 231 * MiB;
constexpr size_t R_C = 0, R_U = (size_t)MT * 512 * 2, R_MIX = 2 * R_U, R_Q = R_MIX + (size_t)MT * 1024 * 2, R_XA = R_Q + (size_t)MT * 1024 * 2;
constexpr size_t WS_END = WS_R + (size_t)MT * 4096 * 2;
constexpr size_t H_CH = 0, H_UH = (size_t)4 * 8 * 30 * 512 * 2;
static_assert(WS_HIST + H_UH + (size_t)4 * 8 * 15 * 512 * 2 <= WS_SSQ && WS_SSQ + (size_t)13 * MT * 8 <= WS_W && WS_W + DEPTH * WL_STRIDE <= WS_XB && WS_XB + (size_t)MT * 2048 <= WS_PB && WS_PB + (size_t)DEPTH * MT * 512 <= WS_R && R_XA + (size_t)MT * 2048 <= (size_t)MT * 8192 && WS_END <= 512 * MiB, "d_ws map");
constexpr size_t OUT_Y = 0, OUT_NCP = (size_t)MT * DM, OUT_NPP = OUT_NCP + (size_t)DEPTH * NB * HC * DCONV, OUT_NCS = OUT_NPP + (size_t)DEPTH * NB * HP * DPOOL, OUT_NPS = OUT_NCS + (size_t)DEPTH * NB * HC * DCONV, OUT_END = OUT_NPS + (size_t)DEPTH * NB * HP * DPOOL;
constexpr int LDS_BYTES = 147456;
constexpr int MISC_OFF = 131072 + 320;

#define LAS __attribute__((address_space(3)))
typedef unsigned short bf16;
typedef unsigned v4u __attribute__((ext_vector_type(4)));
typedef unsigned v2u __attribute__((ext_vector_type(2)));
typedef float f32x4 __attribute__((ext_vector_type(4)));
#define LDS_WAIT() asm volatile("s_waitcnt lgkmcnt(0)" ::: "memory")
__device__ __forceinline__ unsigned pk2(float lo, float hi) { return pg8::cvt_pk_bf16(lo, hi); }
__device__ __forceinline__ float bf_lo(unsigned w) { return __uint_as_float(w << 16); }
__device__ __forceinline__ float bf_hi(unsigned w) { return __uint_as_float(w & 0xffff0000u); }
__device__ __forceinline__ float wave_sum(float v) {
#pragma unroll
    for (int o = 1; o < 64; o <<= 1) v += __shfl_xor(v, o);
    return v;
}

struct Args { const float* in[22]; float* out; unsigned char* ws; };
enum { I_XP = 0, I_XS, I_PP, I_PS, I_CC, I_CP, I_WIN, I_CONVW, I_CONVB, I_LNG, I_LNB, I_POOLW, I_PSCALE, I_WOUT, I_GMIX, I_GFFN, I_GPLE, I_WFF1, I_WFF2, I_WPLE, I_WGATE, I_GFINAL };

struct TrDesc { const float* W; const float* g; bf16* WT; int ldw, k0, n0, ldd, drow0; };
__device__ __forceinline__ void tr_load(const TrDesc& d, float (&v)[32], int lane) {
#pragma unroll
    for (int i = 0; i < 32; ++i) v[i] = d.W[(size_t)(d.k0 + 2 * i + (lane >> 5)) * d.ldw + d.n0 + (lane & 31)];
}
__device__ __forceinline__ void tr_store(const TrDesc& d, const float (&v)[32], LAS float* scr, int lane) {
#pragma unroll
    for (int i = 0; i < 32; ++i) scr[(2 * i + (lane >> 5)) * 33 + (lane & 31)] = v[i];
    const int c = lane & 7;
    f32x4 g0 = (f32x4){1.f, 1.f, 1.f, 1.f}, g1 = g0;
    if (d.g) { g0 = *(const f32x4*)(d.g + d.k0 + 8 * c); g1 = *(const f32x4*)(d.g + d.k0 + 8 * c + 4); }
    LDS_WAIT(); asm volatile("" ::: "memory");
#pragma unroll
    for (int j = 0; j < 4; ++j) { const int n = (lane >> 3) + 8 * j; const LAS float* s = scr + (8 * c) * 33 + n;
        v4u o; o.x = pk2(s[0 * 33] * g0[0], s[1 * 33] * g0[1]); o.y = pk2(s[2 * 33] * g0[2], s[3 * 33] * g0[3]); o.z = pk2(s[4 * 33] * g1[0], s[5 * 33] * g1[1]); o.w = pk2(s[6 * 33] * g1[2], s[7 * 33] * g1[3]);
        *(v4u*)(d.WT + (size_t)(d.drow0 + n) * d.ldd + d.k0 + 8 * c) = o; }
    LDS_WAIT(); asm volatile("" ::: "memory");
}
__device__ __forceinline__ int win_row(int n) { return n < 512 ? ((n >> 7) * 256 + (n & 127)) : (n < 1024 ? (((n - 512) >> 7) * 256 + 128 + (n & 127)) : n); }

__device__ __forceinline__ void prologue(const Args& a, LAS unsigned char* lds) {
    int tid_ = threadIdx.x; asm volatile("" : "+v"(tid_));
    const int tid = tid_, lane = tid & 63, wave = __builtin_amdgcn_readfirstlane(tid >> 6);
    const int G = gridDim.x, gw = blockIdx.x * NWAVES + wave, NGW = G * NWAVES;
    const size_t gt = (size_t)blockIdx.x * NTHR + tid, NGT = (size_t)G * NTHR;
    unsigned char* ws = a.ws;
    LAS float* scr = (LAS float*)(lds + wave * 16384);
    constexpr int IT_IN = 16 * 48, IT_OUT = 8 * 32, IT_FF1 = 16 * 128, IT_FF2 = 64 * 32, IT_GATE = 16 * 32, IT_PLE = 4 * 32, IT_L = IT_IN + IT_OUT + IT_FF1 + IT_FF2 + IT_GATE + IT_PLE;
#ifndef REP_T
#define REP_T 1
#endif
#ifndef REP_X
#define REP_X 1
#endif
    auto desc = [&](int it) -> TrDesc {
        const int l = it / IT_L; int r = it - l * IT_L; unsigned char* wl = ws + WS_W + (size_t)l * WL_STRIDE; TrDesc d;
        if (r < IT_IN) { const int kb = r / 48, nb = r % 48; d = TrDesc{a.in[I_WIN] + (size_t)l * DM * NIN, a.in[I_GMIX] + l * DM, (bf16*)(wl + WL_IN), NIN, 64 * kb, 32 * nb, DM, win_row(32 * nb)}; return d; } r -= IT_IN;
        if (r < IT_OUT) { const int kb = r / 32, nb = r % 32; d = TrDesc{a.in[I_WOUT] + (size_t)l * DM * DM, nullptr, (bf16*)(wl + WL_OUT), DM, 64 * kb, 32 * nb, DM, 32 * nb}; return d; } r -= IT_OUT;
        if (r < IT_FF1) { const int kb = r / 128, nb = r % 128; d = TrDesc{a.in[I_WFF1] + (size_t)l * DM * DFF, a.in[I_GFFN] + l * DM, (bf16*)(wl + WL_FF1), DFF, 64 * kb, 32 * nb, DM, 32 * nb}; return d; } r -= IT_FF1;
        if (r < IT_FF2) { const int kb = r / 32, nb = r % 32; d = TrDesc{a.in[I_WFF2] + (size_t)l * DFF * DM, nullptr, (bf16*)(wl + WL_FF2), DM, 64 * kb, 32 * nb, DFF, 32 * nb}; return d; } r -= IT_FF2;
        if (r < IT_GATE) { const int kb = r / 32, nb = r % 32; d = TrDesc{a.in[I_WGATE] + (size_t)l * DM * DM, a.in[I_GPLE] + l * DM, (bf16*)(wl + WL_GATE), DM, 64 * kb, 32 * nb, DM, 32 * nb}; return d; } r -= IT_GATE;
        { const int kb = r / 32, nb = r % 32; d = TrDesc{a.in[I_WPLE] + (size_t)l * PLE * DM, nullptr, (bf16*)(wl + WL_PLE), DM, 64 * kb, 32 * nb, PLE, 32 * nb}; return d; }
    };
    for (int rep = 0; rep < REP_T; ++rep)
    for (int it = gw; it < DEPTH * IT_L; it += 2 * NGW) {
        const bool two = it + NGW < DEPTH * IT_L;
        const TrDesc dA = desc(it), dB = desc(two ? it + NGW : it);
        float vA[32], vB[32];
        tr_load(dA, vA, lane); if (two) tr_load(dB, vB, lane);
        tr_store(dA, vA, scr, lane); if (two) tr_store(dB, vB, scr, lane);
    }
    for (size_t w = gt; w < (size_t)DEPTH * 4 * 16 * 256; w += NGT) {
        const int n4 = (int)(w & 255); const int hi = __builtin_amdgcn_readfirstlane((int)(w >> 8)); const int cb = hi & 15, g = (hi >> 4) & 3, l = hi >> 6;
        const float* wo = a.in[I_WOUT] + (size_t)l * DM * DM + (size_t)(512 + 128 * g) * DM + 4 * n4; const float* sc = a.in[I_PSCALE] + l * DPOOL + 128 * g;
        const float* pw = a.in[I_POOLW] + ((size_t)(l * 4 + g) * 128 + 8 * cb) * 128;
        f32x4 acc[8];
#pragma unroll
        for (int j = 0; j < 8; ++j) acc[j] = (f32x4){0.f, 0.f, 0.f, 0.f};
#pragma unroll 8
        for (int d = 0; d < 128; ++d) { const f32x4 wv = *(const f32x4*)(wo + (size_t)d * DM) * sc[d];
#pragma unroll
            for (int j = 0; j < 8; ++j) acc[j] += wv * pw[j * 128 + d]; }
        bf16* dst = (bf16*)(ws + WS_W + (size_t)l * WL_STRIDE + WL_OUT) + (size_t)(4 * n4) * DM + 512 + 128 * g + 8 * cb;
#pragma unroll
        for (int i = 0; i < 4; ++i) { v4u o; o.x = pk2(acc[0][i], acc[1][i]); o.y = pk2(acc[2][i], acc[3][i]); o.z = pk2(acc[4][i], acc[5][i]); o.w = pk2(acc[6][i], acc[7][i]); *(v4u*)(dst + (size_t)i * DM) = o; }
    }
    for (int rep = 0; rep < REP_X; ++rep) {
    pg8::ssq_t* ssq = (pg8::ssq_t*)(ws + WS_SSQ);
    for (int r0 = gw; r0 < MT; r0 += 2 * NGW) {
        f32x4 v[2][4];
#pragma unroll
        for (int u = 0; u < 2; ++u) { const int r = r0 + u * NGW; if (r < MT) { const float* xr = (r < MP) ? a.in[I_XP] + (size_t)r * DM : a.in[I_XS] + (size_t)(r - MP) * DM;
#pragma unroll
            for (int j = 0; j < 4; ++j) v[u][j] = *((const f32x4*)xr + lane + 64 * j); } }
#pragma unroll
        for (int u = 0; u < 2; ++u) { const int r = r0 + u * NGW; if (r < MT) { bf16* o = (bf16*)(ws + WS_R + R_XA) + (size_t)r * DM; float s = 0.f;
#pragma unroll
            for (int j = 0; j < 4; ++j) { const f32x4 t = v[u][j]; s += (t[0] * t[0] + t[1] * t[1]) + (t[2] * t[2] + t[3] * t[3]);
                v2u p; p.x = pk2(t[0], t[1]); p.y = pk2(t[2], t[3]); *((v2u*)o + lane + 64 * j) = p; }
            s = wave_sum(s); if (lane == 0) ssq[r] = (pg8::ssq_t)(s * 1048576.0f); } }
    }
    for (size_t i = gt; i < (size_t)12 * MT; i += NGT) ssq[MT + i] = 0ull;
    for (size_t i = gt; i < (size_t)DEPTH * NB * (HC + HP) * 256; i += NGT) {
        const size_t nc = (size_t)DEPTH * NB * HC * 256;
        if (i < nc) { const float* s = a.in[I_CC] + 2 * i; *((unsigned*)(ws + WS_HIST + H_CH) + i) = pk2(s[0], s[1]); }
        else { const size_t k = i - nc; const float* s = a.in[I_CP] + 2 * k; *((unsigned*)(ws + WS_HIST + H_UH) + k) = pk2(s[0], s[1]); }
    }
    constexpr size_t NPI = (size_t)DEPTH * MT * (PLE / 8);
    for (size_t i0 = gt; i0 < NPI; i0 += 4 * NGT) {
        f32x4 v0[4], v1[4];
#pragma unroll
        for (int u = 0; u < 4; ++u) { const size_t i = i0 + u * NGT; if (i < NPI) {
            const int c8 = (int)(i & 31); const size_t lr = i >> 5; const int l = (int)(lr / MT), r = (int)(lr % MT);
            const float* src = (r < MP) ? a.in[I_PP] + ((size_t)l * MP + r) * PLE : a.in[I_PS] + ((size_t)l * MS + (r - MP)) * PLE;
            v0[u] = *((const f32x4*)src + 2 * c8); v1[u] = *((const f32x4*)src + 2 * c8 + 1); } }
#pragma unroll
        for (int u = 0; u < 4; ++u) { const size_t i = i0 + u * NGT; if (i < NPI) {
            v4u o; o.x = pk2(v0[u][0], v0[u][1]); o.y = pk2(v0[u][2], v0[u][3]); o.z = pk2(v1[u][0], v1[u][1]); o.w = pk2(v1[u][2], v1[u][3]);
            *((v4u*)(ws + WS_PB) + i) = o; } }
    }
    }
}

typedef float f32x2 __attribute__((ext_vector_type(2)));
template <int CTRL> __device__ __forceinline__ float dpp_mov(float v) { return __builtin_bit_cast(float, __builtin_amdgcn_update_dpp(0, __builtin_bit_cast(int, v), CTRL, 0xF, 0xF, true)); }
__device__ __forceinline__ float row16_sum(float v) {
    v += dpp_mov<0xB1>(v); v += dpp_mov<0x4E>(v); v += dpp_mov<0x141>(v); v += dpp_mov<0x140>(v); return v;
}
template <int W, int R> __device__ __forceinline__ void pool_load(unsigned (&pk)[31], const bf16* U, const bf16* hist, bool samp, int seqbase, int tb, int cp) {
#pragma unroll
    for (int j = 0; j < W + R - 1; ++j) { const int t = tb - (W - 1) + j;
        const bf16* src = t >= 0 ? U + (size_t)(seqbase + t) * 512 : (samp ? hist + (size_t)(HP + t) * DPOOL : U);
        pk[j] = *(const unsigned*)(src + 2 * cp); }
}
template <int W, int R> __device__ __forceinline__ void pool_rows(const unsigned (&pk)[31], bool samp, int tb, int pos0, bf16* mixrow) {
    f32x2 a[W + R - 1];
#pragma unroll
    for (int j = 0; j < W + R - 1; ++j) { const int t = tb - (W - 1) + j; const bool valid = (t >= 0) || samp; a[j] = valid ? (f32x2){bf_lo(pk[j]), bf_hi(pk[j])} : (f32x2){0.f, 0.f}; }
    f32x2 s = (f32x2){0.f, 0.f};
#pragma unroll
    for (int k = 0; k < W; ++k) s += a[k];
#pragma unroll
    for (int i = 0; i < R; ++i) {
        if (i > 0) { if (W >= 8) { s += a[i + W - 1]; s -= a[i - 1]; }
                     else { s = (f32x2){0.f, 0.f};
#pragma unroll
                            for (int k = 0; k < W; ++k) s += a[i + k]; } }
        const int pos = pos0 + tb + i; const float inv = 1.0f / (float)(pos + 1 < W ? pos + 1 : W);
        *(unsigned*)(mixrow + (size_t)i * 1024) = pk2(s.x * inv - a[i + W - 1].x, s.y * inv - a[i + W - 1].y); }
}
template <int R> __device__ __forceinline__ void pb_item(int r0, bool samp, int l, const bf16* C, const bf16* U, bf16* MIX, const unsigned char* ws, const LAS f32x2* wl, f32x2 cb, f32x2 lg, f32x2 lb,
                                                         LAS f32x2* red, LAS f32x2* st, int tid, int lane, int half, int wq, int cp) {
    int b, t0, seqbase; if (!samp) { b = r0 >> 12; t0 = r0 & 4095; seqbase = b << 12; } else { const int rr = r0 - MP; b = rr >> 6; t0 = rr & 63; seqbase = MP + (b << 6); }
    const int tb = t0 + R * half, pos0 = samp ? PAST : 0;
    const bf16* chist = (const bf16*)(ws + WS_HIST + H_CH) + (size_t)(l * NB + b) * HC * DCONV;
    const bf16* uhist = (const bf16*)(ws + WS_HIST + H_UH) + (size_t)(l * NB + b) * HP * DPOOL;
    unsigned pk[R + 30];
#pragma unroll
    for (int j = 0; j < R + 30; ++j) { const int t = tb - HC + j;
        const bf16* src = t >= 0 ? C + (size_t)(seqbase + t) * 512 : (samp ? chist + (size_t)(HC + t) * DCONV : C);
        pk[j] = *(const unsigned*)(src + 2 * cp); }
    unsigned pp[31];
    if (wq == 0) pool_load<2, R>(pp, U, uhist, samp, seqbase, tb, cp); else if (wq == 1) pool_load<4, R>(pp, U, uhist, samp, seqbase, tb, cp);
    else if (wq == 2) pool_load<8, R>(pp, U, uhist, samp, seqbase, tb, cp); else pool_load<16, R>(pp, U, uhist, samp, seqbase, tb, cp);
    f32x2 o[R];
    { f32x2 w[CW];
#pragma unroll
      for (int k = 0; k < CW; ++k) w[k] = wl[k * 256 + cp];
#pragma unroll
      for (int i = 0; i < R; ++i) o[i] = cb;
#pragma unroll
      for (int j = 0; j < R + 30; ++j) { const int t = tb - HC + j; const bool valid = (t >= 0) || samp;
          const f32x2 v = valid ? (f32x2){bf_lo(pk[j]), bf_hi(pk[j])} : (f32x2){0.f, 0.f};
#pragma unroll
          for (int i = 0; i < R; ++i) { const int k = j - i; if (k >= 0 && k < CW) o[i] += w[k] * v; } } }
#pragma unroll
    for (int i = 0; i < R; ++i) { const float s = row16_sum(o[i].x + o[i].y), q = row16_sum(o[i].x * o[i].x + o[i].y * o[i].y);
        if ((lane & 15) == 0) red[(half * R + i) * 16 + wq * 4 + (lane >> 4)] = (f32x2){s, q}; }
    __syncthreads();
    if (tid < 2 * R) { float s = 0.f, q = 0.f;
#pragma unroll
        for (int k = 0; k < 16; ++k) { const f32x2 p = red[tid * 16 + k]; s += p.x; q += p.y; }
        const float mean = s * (1.0f / DCONV), var = q * (1.0f / DCONV) - mean * mean; st[tid] = (f32x2){mean, rsqrtf(fmaxf(var, 0.f) + 1e-6f)}; }
    __syncthreads();
    bf16* mrow = MIX + (size_t)(r0 + R * half) * 1024 + 2 * cp;
#pragma unroll
    for (int i = 0; i < R; ++i) { const f32x2 ms = st[half * R + i];
        float y0 = (o[i].x - ms.x) * ms.y * lg.x + lb.x, y1 = (o[i].y - ms.x) * ms.y * lg.y + lb.y; y0 *= pg8::sigm(y0); y1 *= pg8::sigm(y1);
        *(unsigned*)(mrow + (size_t)i * 1024) = pk2(y0, y1); }
    bf16* prow = mrow + 512;
    if (wq == 0) pool_rows<2, R>(pp, samp, tb, pos0, prow); else if (wq == 1) pool_rows<4, R>(pp, samp, tb, pos0, prow);
    else if (wq == 2) pool_rows<8, R>(pp, samp, tb, pos0, prow); else pool_rows<16, R>(pp, samp, tb, pos0, prow);
}

__device__ __forceinline__ void phase_b(const Args& a, int l, LAS unsigned char* lds) {
    int tid_ = threadIdx.x; asm volatile("" : "+v"(tid_));
    const int tid = tid_, lane = tid & 63, wave = __builtin_amdgcn_readfirstlane(tid >> 6), half = wave >> 2, wq = wave & 3, cp = wq * 64 + lane;
    unsigned char* ws = a.ws;
    const bf16* C = (const bf16*)(ws + WS_R + R_C); const bf16* U = (const bf16*)(ws + WS_R + R_U); bf16* MIX = (bf16*)(ws + WS_R + R_MIX);
    LAS f32x2* red = (LAS f32x2*)lds;
    LAS f32x2* st = (LAS f32x2*)(lds + 4096);
    LAS f32x2* wl = (LAS f32x2*)(lds + 8192);
    { const f32x2* cw = (const f32x2*)(a.in[I_CONVW] + (size_t)l * CW * DCONV);
      for (int i = tid; i < CW * 256; i += NTHR) wl[i] = cw[i];
      __syncthreads(); }
    const f32x2 cb = *(const f32x2*)(a.in[I_CONVB] + l * DCONV + 2 * cp), lg = *(const f32x2*)(a.in[I_LNG] + l * DCONV + 2 * cp), lb = *(const f32x2*)(a.in[I_LNB] + l * DCONV + 2 * cp);
    for (int ib = blockIdx.x; ib < MP / 32; ib += gridDim.x) pb_item<16>(ib * 32, false, l, C, U, MIX, ws, wl, cb, lg, lb, red, st, tid, lane, half, wq, cp);
    for (int jb = blockIdx.x; jb < MS / 2; jb += gridDim.x) pb_item<1>(MP + jb * 2, true, l, C, U, MIX, ws, wl, cb, lg, lb, red, st, tid, lane, half, wq, cp);
    const size_t gt = (size_t)blockIdx.x * NTHR + tid, NGT = (size_t)gridDim.x * NTHR;
    constexpr int NC = NB * HC * DCONV, NPL = NB * HP * DPOOL;
    for (size_t i = gt; i < (size_t)2 * (NC + NPL); i += NGT) { int r = (int)i; float* out = a.out;
        if (r < NC) { const int ch = r & 511, j = (r >> 9) % HC, b = (r >> 9) / HC; out[OUT_NCP + (size_t)l * NC + r] = bf_lo(C[((size_t)b * SEQ + SEQ - HC + j) * 512 + ch]); continue; } r -= NC;
        if (r < NPL) { const int ch = r & 511, j = (r >> 9) % HP, b = (r >> 9) / HP; out[OUT_NPP + (size_t)l * NPL + r] = bf_lo(U[((size_t)b * SEQ + SEQ - HP + j) * 512 + ch]); continue; } r -= NPL;
        if (r < NC) { const int ch = r & 511, j = (r >> 9) % HC, b = (r >> 9) / HC; out[OUT_NCS + (size_t)l * NC + r] = bf_lo(C[((size_t)MP + b * DSEQ + DSEQ - HC + j) * 512 + ch]); continue; } r -= NC;
        { const int ch = r & 511, j = (r >> 9) % HP, b = (r >> 9) / HP; out[OUT_NPS + (size_t)l * NPL + r] = bf_lo(U[((size_t)MP + b * DSEQ + DSEQ - HP + j) * 512 + ch]); }
    }
}

#define XB_TMO      128
#define XB_XCNT(j)  (256  + 64 * (j))
#define XB_XSUB(j)  (1280 + 64 * (j))
#define XB_XGEN(j)  (2304 + 64 * (j))
#define XB_TOP      3328
#define XB_TOPGEN   3392
#define XCD_BAR_WORDS 3456
#define XB_SPIN_CAP (1u << 18)

__device__ __forceinline__ unsigned xb_ld(unsigned* p)              { return __hip_atomic_load(p, __ATOMIC_RELAXED, __HIP_MEMORY_SCOPE_AGENT); }
__device__ __forceinline__ unsigned xb_add(unsigned* p, unsigned v) { return __hip_atomic_fetch_add(p, v, __ATOMIC_RELAXED, __HIP_MEMORY_SCOPE_AGENT); }
__device__ __forceinline__ unsigned xb_xcc_id() { return (unsigned)__builtin_amdgcn_s_getreg((3 << 11) | 20) & 0xFu; }
#define XB_SPIN(cond, bar) do { unsigned _sp = 0; while (cond) { __builtin_amdgcn_s_sleep(1); \
    if ((++_sp & 255u) == 0u) { if (xb_ld(&(bar)[XB_TMO])) break; if (_sp > XB_SPIN_CAP) { atomicAdd(&(bar)[XB_TMO], 1u); break; } } } } while (0)

struct XcdBarrier {
    unsigned* bar; unsigned x;
    volatile LAS unsigned* st;
};

__device__ __forceinline__ XcdBarrier xcd_barrier_post(unsigned* bar, volatile LAS unsigned* st) {
    XcdBarrier b; b.bar = bar; b.x = xb_xcc_id(); b.st = st;
    if (threadIdx.x == 0) (void)xb_add(&bar[XB_XCNT(b.x)], 1u);
    return b;
}
__device__ __forceinline__ void xcd_barrier_complete(unsigned* bar, unsigned x, unsigned& nloc, unsigned& nx) {
    const unsigned G = gridDim.x * gridDim.y * gridDim.z;
    unsigned sum, cnt, mine, sp = 0u;
    for (;;) {
        sum = 0u; cnt = 0u; mine = 0u;
#pragma unroll
        for (unsigned j = 0; j < 16; ++j) { const unsigned c = xb_ld(&bar[XB_XCNT(j)]); sum += c; cnt += (c > 0u) ? 1u : 0u; mine = (j == x) ? c : mine; }
        if (sum == G) break;
        __builtin_amdgcn_s_sleep(1);
        if ((++sp & 255u) == 0u) { if (xb_ld(&bar[XB_TMO])) break; if (sp > XB_SPIN_CAP) { atomicAdd(&bar[XB_TMO], 1u); break; } }
    }
    nloc = mine > 0u ? mine : 1u; nx = cnt > 0u ? cnt : 1u;
}

__device__ __forceinline__ void xcd_barrier(const XcdBarrier& b) {
    asm volatile("s_waitcnt vmcnt(0)" ::: "memory");
    __syncthreads();
    if (threadIdx.x == 0) {
        unsigned* bar = b.bar;
        __builtin_amdgcn_s_waitcnt(0);
        unsigned nloc = b.st[0], nx = b.st[1];
        if (nloc == 0u) { xcd_barrier_complete(bar, b.x, nloc, nx); b.st[0] = nloc; b.st[1] = nx; }
        const unsigned old = xb_add(&bar[XB_XSUB(b.x)], 1u);
        const unsigned gen = old / nloc;
        if (old + 1u == (gen + 1u) * nloc) {
            __builtin_amdgcn_fence(__ATOMIC_RELEASE, "agent");
            asm volatile("s_waitcnt vmcnt(0)" ::: "memory");
            const unsigned og = xb_add(&bar[XB_TOP], 1u);
            const unsigned tg = og / nx;
            if (og + 1u == (tg + 1u) * nx) xb_add(&bar[XB_TOPGEN], 1u);
            else XB_SPIN(xb_ld(&bar[XB_TOPGEN]) == tg, bar);
            __builtin_amdgcn_fence(__ATOMIC_ACQUIRE, "agent");
            xb_add(&bar[XB_XGEN(b.x)], 1u);
            asm volatile("s_waitcnt vmcnt(0)" ::: "memory");
        } else {
            XB_SPIN(xb_ld(&bar[XB_XGEN(b.x)]) == gen, bar);
            __builtin_amdgcn_fence(__ATOMIC_ACQUIRE, "agent");
            asm volatile("s_waitcnt vmcnt(0)" ::: "memory");
        }
    }
    __syncthreads();
}

__global__ void __launch_bounds__(NTHR, 2) mk_fwd(Args a) {
    extern __shared__ __attribute__((aligned(16))) unsigned char lds_raw[];
    LAS unsigned char* lds = (LAS unsigned char*)lds_raw;
    cg::grid_group grid = cg::this_grid();
    volatile LAS unsigned* MISC = (volatile LAS unsigned*)(lds + MISC_OFF);
    if (threadIdx.x < 32) MISC[threadIdx.x] = 0u;
    __syncthreads();
    const XcdBarrier bar = xcd_barrier_post((unsigned*)(a.ws + WS_CTL), MISC + 8);
#define GRID_BAR() xcd_barrier(bar)
    unsigned char* ws = a.ws;
    pg8::ssq_t* ssq = (pg8::ssq_t*)(ws + WS_SSQ); float* X = a.out;
    bf16* XB = (bf16*)(ws + WS_XB); bf16* XA = (bf16*)(ws + WS_R + R_XA);
    bf16* Cb = (bf16*)(ws + WS_R + R_C); bf16* Ub = (bf16*)(ws + WS_R + R_U); bf16* MIX = (bf16*)(ws + WS_R + R_MIX); bf16* Qb = (bf16*)(ws + WS_R + R_Q); bf16* Hb = (bf16*)(ws + WS_R);
    const int G = gridDim.x, c = blockIdx.x;
#ifndef REP_B
#define REP_B 1
#endif
#ifndef REP_D
#define REP_D 1
#endif
#ifndef REP_S
#define REP_S 1
#endif
    prologue(a, lds);
    asm volatile("s_waitcnt vmcnt(0) lgkmcnt(0)" ::: "memory"); __syncthreads();
    grid.sync();
    __builtin_amdgcn_fence(__ATOMIC_ACQUIRE, "agent"); asm volatile("s_waitcnt vmcnt(0)" ::: "memory"); __syncthreads();
    const int alt = c & 1;
#pragma unroll 1
    for (int l = 0; l < DEPTH; ++l) {
        const unsigned char* wl = ws + WS_W + (size_t)l * WL_STRIDE;
#pragma unroll 1
        for (int st = 0; st < 2; ++st) {
            if ((st ^ alt) == 0) { pg8::Gemm g{XA, (const bf16*)(wl + WL_IN), MT, NIN, DM}; pg8::StaticOrder S; S.init(MP, NIN, G, c);
                pg8::EpiGLU E{Cb, Ub, ssq + (size_t)(3 * l) * MT};
                pg8::gemm_phase<pg8::EpiGLU, pg8::StaticOrder, true, true>(lds, g, S, E); }
            else { sg::SGlu SE{Cb, Ub, ssq + (size_t)(3 * l) * MT}; sg::small_gemm<true, 4, 4, sg::SGlu>(lds, XA, (const bf16*)(wl + WL_IN), NIN, DM, SE); } }
        GRID_BAR();
        phase_b(a, l, lds);
        GRID_BAR();
#pragma unroll 1
        for (int st = 0; st < 2; ++st) {
            if ((st ^ alt) == 0) { pg8::Gemm g{MIX, (const bf16*)(wl + WL_OUT), MT, DM, DM}; pg8::StaticOrder S; S.init(MP, DM, G, c);
                pg8::EpiRes E{XA, XB, ssq + (size_t)(3 * l + 1) * MT};
                pg8::gemm_phase<pg8::EpiRes, pg8::StaticOrder, true, true>(lds, g, S, E); }
            else { sg::SRes SE{XA, XB, ssq + (size_t)(3 * l + 1) * MT}; sg::small_gemm<false, 4, 2, sg::SRes>(lds, MIX, (const bf16*)(wl + WL_OUT), DM, DM, SE); } }
        GRID_BAR();
#pragma unroll 1
        for (int st = 0; st < 2; ++st) {
            if ((st ^ alt) == 0) { pg8::Gemm g{XB, (const bf16*)(wl + WL_FF1), MT, DFF, DM}; pg8::StaticOrder S; S.init(MP, DFF, G, c);
                int tidp = threadIdx.x; asm volatile("" : "+v"(tidp));
                pg8::rs_preload((LAS float*)(lds + pg8::RS_OFF), ssq + (size_t)(3 * l + 1) * MT, S, tidp);
                pg8::EpiRelu2 E{Hb, ssq + (size_t)(3 * l + 1) * MT, (const LAS float*)(lds + pg8::RS_OFF), 0};
                pg8::gemm_phase<pg8::EpiRelu2, pg8::StaticOrder, true, true>(lds, g, S, E); }
            else { sg::SRelu2 SE{Hb, ssq + (size_t)(3 * l + 1) * MT}; sg::small_gemm<false, 4, 4, sg::SRelu2>(lds, XB, (const bf16*)(wl + WL_FF1), DFF, DM, SE); } }
        GRID_BAR();
#pragma unroll 1
        for (int st = 0; st < 2; ++st) {
            if ((st ^ alt) == 0) { pg8::Gemm g{Hb, (const bf16*)(wl + WL_FF2), MT, DM, DFF}; pg8::StaticOrder S; S.init(MP, DM, G, c);
                pg8::EpiRes E{XB, XB, ssq + (size_t)(3 * l + 2) * MT};
                pg8::gemm_phase<pg8::EpiRes, pg8::StaticOrder, true, true>(lds, g, S, E); }
            else { sg::SRes SE{XB, XB, ssq + (size_t)(3 * l + 2) * MT}; sg::small_gemm<false, 4, 2, sg::SRes>(lds, Hb, (const bf16*)(wl + WL_FF2), DM, DFF, SE); } }
        GRID_BAR();
#pragma unroll 1
        for (int st = 0; st < 4; ++st) { const int op = (st + 2 * alt) & 3;
            if (op == 0) { pg8::Gemm g{(const bf16*)(ws + WS_PB) + (size_t)l * MT * PLE, (const bf16*)(wl + WL_PLE), MT, DM, PLE}; pg8::StaticOrder S; S.init(MP, DM, G, c);
                pg8::EpiQ E{Qb};
                pg8::gemm_phase<pg8::EpiQ, pg8::StaticOrder, true, true>(lds, g, S, E); }
            else if (op == 1) { pg8::Gemm g{XB, (const bf16*)(wl + WL_GATE), MT, DM, DM}; pg8::StaticOrder S; S.init(MP, DM, G, c);
                pg8::EpiGate E{Qb, XB, XA, ssq + (size_t)(3 * l + 2) * MT, ssq + (size_t)(3 * l + 3) * MT};
                pg8::gemm_phase<pg8::EpiGate, pg8::StaticOrder, true, true>(lds, g, S, E); }
            else if (op == 2) { sg::SQ SE{Qb}; sg::small_gemm<false, 1, 2, sg::SQ>(lds, (const bf16*)(ws + WS_PB) + (size_t)l * MT * PLE, (const bf16*)(wl + WL_PLE), DM, PLE, SE); }
            else { sg::SGate SE{Qb, XB, XA, ssq + (size_t)(3 * l + 2) * MT, ssq + (size_t)(3 * l + 3) * MT}; sg::small_gemm<false, 4, 2, sg::SGate>(lds, XB, (const bf16*)(wl + WL_GATE), DM, DM, SE); } }
        GRID_BAR();
    }
    { const int lane = threadIdx.x & 63, gw = blockIdx.x * NWAVES + (threadIdx.x >> 6), NGW = G * NWAVES; const pg8::ssq_t* sq = ssq + (size_t)12 * MT; const float* gf = a.in[I_GFINAL];
      for (int r0 = gw; r0 < MT; r0 += 2 * NGW) {
          v4u xw[2][2]; float rsv[2];
#pragma unroll
          for (int u = 0; u < 2; ++u) { const int r = r0 + u * NGW; if (r < MT) { rsv[u] = pg8::rs_of(sq, r); const v4u* xr = (const v4u*)(XA + (size_t)r * DM); xw[u][0] = xr[lane]; xw[u][1] = xr[lane + 64]; } }
#pragma unroll
          for (int u = 0; u < 2; ++u) { const int r = r0 + u * NGW; if (r < MT) { f32x4* yr = (f32x4*)(X + (size_t)r * DM);
#pragma unroll
              for (int j = 0; j < 2; ++j) { f32x4 v0, v1; pg8::unpack8(xw[u][j], v0, v1); const f32x4 g0 = *((const f32x4*)gf + 2 * (lane + 64 * j)), g1 = *((const f32x4*)gf + 2 * (lane + 64 * j) + 1);
                  yr[2 * (lane + 64 * j)] = v0 * rsv[u] * g0; yr[2 * (lane + 64 * j) + 1] = v1 * rsv[u] * g1; } } } } }
}

extern "C" void kernel_launch(void* const* d_in, const int* in_sizes, int n_in, void* d_out, int out_size, void* d_ws, size_t ws_size, hipStream_t stream) {
    static int grid = 0;
    if (grid == 0) {
        if (n_in != 22 || in_sizes[0] != MP * DM || (size_t)out_size != OUT_END || ws_size < WS_END) { fprintf(stderr, "kernel_launch: unexpected shapes (n_in %d, in0 %d, out %d, ws %zu; need ws >= %zu); nothing launched\n", n_in, n_in > 0 ? in_sizes[0] : -1, out_size, ws_size, (size_t)WS_END); grid = -1; return; }
        int dev = 0, cus = 0, per_cu = 0;
        if (hipGetDevice(&dev) != hipSuccess || hipDeviceGetAttribute(&cus, hipDeviceAttributeMultiprocessorCount, dev) != hipSuccess) { grid = -1; return; }
        if (hipFuncSetAttribute((const void*)mk_fwd, hipFuncAttributeMaxDynamicSharedMemorySize, LDS_BYTES) != hipSuccess) { fprintf(stderr, "kernel_launch: hipFuncSetAttribute failed\n"); grid = -1; return; }
        if (hipOccupancyMaxActiveBlocksPerMultiprocessor(&per_cu, (const void*)mk_fwd, NTHR, LDS_BYTES) != hipSuccess || per_cu < 1) { fprintf(stderr, "kernel_launch: occupancy query says %d\n", per_cu); per_cu = 1; }
        (void)hipGetLastError();
        grid = cus;
    }
    if (grid < 0) return;
    (void)hipMemsetAsync((char*)d_ws + WS_CTL, 0, CTL_ZERO_BYTES, stream);
    Args a{};
    for (int i = 0; i < 22; ++i) a.in[i] = (const float*)d_in[i];
    a.out = (float*)d_out; a.ws = (unsigned char*)d_ws;
    void* args[] = {&a};
    hipError_t e = hipLaunchCooperativeKernel((const void*)mk_fwd, dim3(grid), dim3(NTHR), args, LDS_BYTES, stream);
    if (e != hipSuccess) fprintf(stderr, "kernel_launch: cooperative launch failed: %s (grid %d)\n", hipGetErrorString(e), grid);
}
```

```cpp
#include <hip/hip_runtime.h>
#include <hip/hip_cooperative_groups.h>
#include <cstdio>
#include <cstdint>
namespace cg = cooperative_groups;
namespace pg8 {
#define PG8_LAS __attribute__((address_space(3)))
typedef unsigned short bf16_t;
typedef short bf16x8 __attribute__((ext_vector_type(8)));
typedef float f32x4 __attribute__((ext_vector_type(4)));
typedef unsigned u32x4 __attribute__((ext_vector_type(4)));
constexpr int BM = 256, BK = 64, HALF = 128, HTB = HALF * BK * 2  , STAGE_BYTES = 8 * HTB, NXCD = 8, WGM = 8;

__host__ __device__ __forceinline__ int lds_byte(int r, int c) { const int st = (r >> 4) * 2 + (c >> 5), rr = r & 15, cc = c & 31, ob = rr * 64 + cc * 2; return st * 1024 + (ob ^ (((ob >> 9) & 1) << 5)); }
__host__ __device__ __forceinline__ void stage_rc(int b, int& R, int& C) { const int st = b / 1024, sb = b % 1024, swz = sb ^ (((sb >> 9) & 1) << 5); R = (st >> 1) * 16 + swz / 64; C = (st & 1) * 32 + (swz % 64) / 2; }
__host__ __device__ __forceinline__ int perm32(int rho) { const int n = rho >> 4, i = rho & 15; return 8 * (i >> 2) + 4 * n + (i & 3); }

struct Unit { int pm, pn; };
struct Gemm { const bf16_t* A; const bf16_t* Bt; int M, N, K; };

struct StaticOrder {
    int nM, nN, nwg, G, c;
    __host__ __device__ void init(int M, int N, int G_, int c_) { nM = M / BM; nN = N / BM; nwg = nM * nN; G = G_; c = c_; }
    __host__ __device__ bool next(int i, Unit& u) const {
        const long L = (long)i * G + c; if (L >= nwg) return false;
        int wgid = (int)L; { const int q = nwg / NXCD, r = nwg % NXCD, xcd = wgid % NXCD, off = wgid / NXCD; wgid = (xcd < r ? xcd * (q + 1) : r * (q + 1) + (xcd - r) * q) + off; }
        const int nig = WGM * nN, gid = wgid / nig, fm = gid * WGM, gsz = (nM - fm) < WGM ? (nM - fm) : WGM;
        u.pm = fm + ((wgid % nig) % gsz); u.pn = (wgid % nig) / gsz; return true;
    }
    __device__ __forceinline__ void a_ready(const Unit&) const {}
    __device__ __forceinline__ void done(const Unit&) const {}
};
constexpr int E_MP = 32768;
__device__ __forceinline__ unsigned cvt_pk_bf16(float lo, float hi) { unsigned r; asm volatile("v_cvt_pk_bf16_f32 %0, %1, %2" : "=v"(r) : "v"(lo), "v"(hi)); return r; }
__device__ __forceinline__ float sigm(float x) { return __builtin_amdgcn_rcpf(1.0f + __expf(-x)); }
__device__ __forceinline__ u32x4 pack8(const f32x4 v0, const f32x4 v1) { u32x4 w; w.x = cvt_pk_bf16(v0[0], v0[1]); w.y = cvt_pk_bf16(v0[2], v0[3]); w.z = cvt_pk_bf16(v1[0], v1[1]); w.w = cvt_pk_bf16(v1[2], v1[3]); return w; }
typedef unsigned long long ssq_t;
__device__ __forceinline__ float rs_of(const ssq_t* ssq, int r) { return rsqrtf((float)ssq[r] * (1.0f / (1024.0f * 1048576.0f)) + 1e-6f); }
__device__ __forceinline__ float rs_from(ssq_t v) { return rsqrtf((float)v * (1.0f / (1024.0f * 1048576.0f)) + 1e-6f); }
__device__ __forceinline__ void ssq_add(ssq_t* p, float ss) { atomicAdd(p, (ssq_t)(ss * 1048576.0f)); }

constexpr int RS_SLOTS = 8, RS_OFF = 131072 + 2048;
template <class Sched> __device__ __forceinline__ void rs_preload(PG8_LAS float* rsl, const ssq_t* ssq, const Sched& S, int tid) {
    if (tid < 256) { ssq_t v[RS_SLOTS]; Unit u;
#pragma unroll
        for (int i = 0; i < RS_SLOTS; ++i) v[i] = S.next(i, u) ? ssq[u.pm * BM + tid] : (ssq_t)0;
#pragma unroll
        for (int i = 0; i < RS_SLOTS; ++i) rsl[i * 256 + tid] = rs_from(v[i]); }
    __syncthreads();
}
struct EpiGLU {
    static constexpr bool PERM = true, AFTER_DRAIN = false;
    bf16_t* C; bf16_t* U; const ssq_t* ssq;
    __device__ __forceinline__ void operator()(const f32x4 (&acc)[2][2][4][2], const Unit& u, int wr, int wc, int fr0, int fq0) const {
        int fr = fr0, fq = fq0; asm volatile("" : "+v"(fr), "+v"(fq));
        const int row0 = u.pm * BM + wr * 64 + fr;
        if (u.pn < 4) {
            const int ch0 = u.pn * 128 + wc * 32 + 8 * fq;
#pragma unroll
            for (int ai = 0; ai < 2; ++ai)
#pragma unroll
                for (int m = 0; m < 4; ++m) { const int r = row0 + ai * HALF + m * 16; const float rsv = rs_of(ssq, r);
                    f32x4 c0, c1;
#pragma unroll
                    for (int j = 0; j < 4; ++j) { c0[j] = (acc[ai][0][m][0][j] * rsv) * sigm(acc[ai][1][m][0][j] * rsv); c1[j] = (acc[ai][0][m][1][j] * rsv) * sigm(acc[ai][1][m][1][j] * rsv); }
                    *(u32x4*)(C + (size_t)r * 512 + ch0) = pack8(c0, c1); }
        } else {
            const int uc0 = (u.pn - 4) * 256 + wc * 32 + 8 * fq;
#pragma unroll
            for (int ai = 0; ai < 2; ++ai)
#pragma unroll
                for (int m = 0; m < 4; ++m) { const int r = row0 + ai * HALF + m * 16; const float rsv = rs_of(ssq, r);
#pragma unroll
                    for (int bj = 0; bj < 2; ++bj) *(u32x4*)(U + (size_t)r * 512 + uc0 + bj * HALF) = pack8(acc[ai][bj][m][0] * rsv, acc[ai][bj][m][1] * rsv); }
        }
    }
};
__device__ __forceinline__ void unpack8(const u32x4 w, f32x4& a, f32x4& b) {
    a[0] = __uint_as_float(w.x << 16); a[1] = __uint_as_float(w.x & 0xffff0000u); a[2] = __uint_as_float(w.y << 16); a[3] = __uint_as_float(w.y & 0xffff0000u);
    b[0] = __uint_as_float(w.z << 16); b[1] = __uint_as_float(w.z & 0xffff0000u); b[2] = __uint_as_float(w.w << 16); b[3] = __uint_as_float(w.w & 0xffff0000u); }
__device__ __forceinline__ float sumsq8(const f32x4 a, const f32x4 b) { return (a[0] * a[0] + a[1] * a[1]) + (a[2] * a[2] + a[3] * a[3]) + (b[0] * b[0] + b[1] * b[1]) + (b[2] * b[2] + b[3] * b[3]); }
struct EpiRes {
    static constexpr bool PERM = true, AFTER_DRAIN = false;
    const bf16_t* base; bf16_t* XB; ssq_t* ssq_out;
    __device__ __forceinline__ void operator()(const f32x4 (&acc)[2][2][4][2], const Unit& u, int wr, int wc, int fr0, int fq0) const {
        int fr = fr0, fq = fq0; asm volatile("" : "+v"(fr), "+v"(fq));
        const int row0 = u.pm * BM + wr * 64 + fr, col0 = u.pn * BM + wc * 32 + 8 * fq;
        u32x4 bw[2][4][2];
#pragma unroll
        for (int m = 0; m < 4; ++m)
#pragma unroll
            for (int bj = 0; bj < 2; ++bj) bw[0][m][bj] = *(const u32x4*)(base + (size_t)(row0 + m * 16) * 1024 + col0 + bj * HALF);
#pragma unroll
        for (int m = 0; m < 2; ++m)
#pragma unroll
            for (int bj = 0; bj < 2; ++bj) bw[1][m][bj] = *(const u32x4*)(base + (size_t)(row0 + HALF + m * 16) * 1024 + col0 + bj * HALF);
        __builtin_amdgcn_sched_barrier(0);
#pragma unroll
        for (int ai = 0; ai < 2; ++ai) {
#pragma unroll
            for (int m = 0; m < 4; ++m) { const int r = row0 + ai * HALF + m * 16; float ss = 0.f;
#pragma unroll
                for (int bj = 0; bj < 2; ++bj) { const size_t off = (size_t)r * 1024 + col0 + bj * HALF;
                    f32x4 b0, b1; unpack8(bw[ai][m][bj], b0, b1);
                    const u32x4 w = pack8(b0 + acc[ai][bj][m][0], b1 + acc[ai][bj][m][1]); *(u32x4*)(XB + off) = w;
                    unpack8(w, b0, b1); ss += sumsq8(b0, b1); }
                ss += __shfl_xor(ss, 16); ss += __shfl_xor(ss, 32);
                if (fq == 0) ssq_add(ssq_out + r, ss);
                if (ai == 0 && m == 1) {
                    __builtin_amdgcn_sched_barrier(0);
#pragma unroll
                    for (int m2 = 2; m2 < 4; ++m2)
#pragma unroll
                        for (int bj = 0; bj < 2; ++bj) bw[1][m2][bj] = *(const u32x4*)(base + (size_t)(row0 + HALF + m2 * 16) * 1024 + col0 + bj * HALF);
                    __builtin_amdgcn_sched_barrier(0); } }
        }
        __builtin_amdgcn_sched_barrier(0);
    }
};
struct EpiRelu2 {
    static constexpr bool PERM = true, AFTER_DRAIN = false;
    bf16_t* H; const ssq_t* ssq; const PG8_LAS float* rsl; mutable int ui;
    __device__ __forceinline__ void operator()(const f32x4 (&acc)[2][2][4][2], const Unit& u, int wr, int wc, int fr0, int fq0) const {
        int fr = fr0, fq = fq0; asm volatile("" : "+v"(fr), "+v"(fq));
        const int row0 = u.pm * BM + wr * 64 + fr, col0 = u.pn * BM + wc * 32 + 8 * fq;
        const int slot = ui; ++ui;
#pragma unroll
        for (int ai = 0; ai < 2; ++ai)
#pragma unroll
            for (int m = 0; m < 4; ++m) { const int r = row0 + ai * HALF + m * 16; const float rsv = slot < RS_SLOTS ? rsl[slot * 256 + ai * HALF + wr * 64 + m * 16 + fr] : rs_of(ssq, r);
#pragma unroll
                for (int bj = 0; bj < 2; ++bj) { f32x4 v0 = acc[ai][bj][m][0] * rsv, v1 = acc[ai][bj][m][1] * rsv;
#pragma unroll
                    for (int j = 0; j < 4; ++j) { v0[j] = fmaxf(v0[j], 0.f); v1[j] = fmaxf(v1[j], 0.f); }
                    *(u32x4*)(H + (size_t)r * 4096 + col0 + bj * HALF) = pack8(v0 * v0, v1 * v1); } }
    }
};
struct EpiQ {
    static constexpr bool PERM = true, AFTER_DRAIN = false;
    bf16_t* Q;
    __device__ __forceinline__ void operator()(const f32x4 (&acc)[2][2][4][2], const Unit& u, int wr, int wc, int fr0, int fq0) const {
        int fr = fr0, fq = fq0; asm volatile("" : "+v"(fr), "+v"(fq));
        const int row0 = u.pm * BM + wr * 64 + fr, col0 = u.pn * BM + wc * 32 + 8 * fq;
#pragma unroll
        for (int ai = 0; ai < 2; ++ai)
#pragma unroll
            for (int m = 0; m < 4; ++m) { const int r = row0 + ai * HALF + m * 16;
#pragma unroll
                for (int bj = 0; bj < 2; ++bj) *(u32x4*)(Q + (size_t)r * 1024 + col0 + bj * HALF) = pack8(acc[ai][bj][m][0], acc[ai][bj][m][1]); }
    }
};
struct EpiGate {
    static constexpr bool PERM = true, AFTER_DRAIN = false;
    const bf16_t* Q; const bf16_t* XBin; bf16_t* XBout; const ssq_t* ssq; ssq_t* ssq_out;
    __device__ __forceinline__ void operator()(const f32x4 (&acc)[2][2][4][2], const Unit& u, int wr, int wc, int fr0, int fq0) const {
        int fr = fr0, fq = fq0; asm volatile("" : "+v"(fr), "+v"(fq));
        const int row0 = u.pm * BM + wr * 64 + fr, col0 = u.pn * BM + wc * 32 + 8 * fq;
#pragma unroll
        for (int ai = 0; ai < 2; ++ai) {
            u32x4 qw[4][2], xw[4][2]; ssq_t sq[4];
#pragma unroll
            for (int m = 0; m < 4; ++m) { sq[m] = ssq[row0 + ai * HALF + m * 16];
#pragma unroll
                for (int bj = 0; bj < 2; ++bj) { const size_t off = (size_t)(row0 + ai * HALF + m * 16) * 1024 + col0 + bj * HALF; qw[m][bj] = *(const u32x4*)(Q + off); xw[m][bj] = *(const u32x4*)(XBin + off); } }
            __builtin_amdgcn_sched_barrier(0);
#pragma unroll
            for (int m = 0; m < 4; ++m) { const int r = row0 + ai * HALF + m * 16; const float rsv = rsqrtf((float)sq[m] * (1.0f / (1024.0f * 1048576.0f)) + 1e-6f); float ss = 0.f;
#pragma unroll
                for (int bj = 0; bj < 2; ++bj) { const size_t off = (size_t)r * 1024 + col0 + bj * HALF;
                    f32x4 q0, q1, x0, x1; unpack8(qw[m][bj], q0, q1); unpack8(xw[m][bj], x0, x1);
                    f32x4 o0, o1;
#pragma unroll
                    for (int j = 0; j < 4; ++j) { o0[j] = x0[j] + sigm(acc[ai][bj][m][0][j] * rsv) * q0[j]; o1[j] = x1[j] + sigm(acc[ai][bj][m][1][j] * rsv) * q1[j]; }
                    const u32x4 w = pack8(o0, o1); *(u32x4*)(XBout + off) = w;
                    unpack8(w, o0, o1); ss += sumsq8(o0, o1); }
                ss += __shfl_xor(ss, 16); ss += __shfl_xor(ss, 32);
                if (fq == 0) ssq_add(ssq_out + r, ss); }
            __builtin_amdgcn_sched_barrier(0);
        }
    }
};
template <class Epi, class Sched, bool ALIGN_EPI = false, bool SP2 = false>
__device__ __forceinline__ void gemm_phase(PG8_LAS unsigned char* lds, const Gemm g, const Sched& S, const Epi& E) {
    int tid_ = threadIdx.x; asm volatile("" : "+v"(tid_));
    const int tid = tid_, wid = __builtin_amdgcn_readfirstlane(tid >> 6), lane = tid & 63, wr = wid >> 2, wc = wid & 3, fr = lane & 15, fq = lane >> 4;
    int K_ = g.K; asm volatile("" : "+s"(K_));
    const int K = K_, nt = K / BK;
    unsigned voffA[2], voffB[2];
#pragma unroll
    for (int i = 0; i < 2; ++i) { int R, C; stage_rc(tid * 16 + i * 8192, R, C); const int Rb = Epi::PERM ? ((R & ~31) + perm32(R & 31)) : R;
        voffA[i] = (unsigned)(R * K + C) * 2u; voffB[i] = (unsigned)(Rb * K + C) * 2u; }
    const size_t kstep = (size_t)(BK * 2);
    const size_t hstep = (size_t)HALF * K * 2;
    const size_t tstep = 2 * hstep;
    const unsigned ldsw = (unsigned)wid * 1024u;
    const int aoff = lds_byte(wr * 64 + fr, fq * 8), boff = lds_byte(wc * 32 + fr, fq * 8);
#define PG8_SA(b, h) (((b) * 2 + (h)) * HTB)
#define PG8_SB(b, h) ((4 + (b) * 2 + (h)) * HTB)
#define PG8_STAGE(bufoff, gbase, voff) do { _Pragma("unroll") for (int _i = 0; _i < 2; ++_i) \
        __builtin_amdgcn_global_load_lds((const unsigned*)((const char*)(gbase) + (voff)[_i]), (PG8_LAS unsigned*)(lds + (bufoff) + ldsw + _i * 8192), 16, 0, 0); } while (0)
#define PG8_LDA(dst, b, h) do { _Pragma("unroll") for (int m = 0; m < 4; ++m) _Pragma("unroll") for (int k = 0; k < 2; ++k) dst[m][k] = *(const PG8_LAS bf16x8*)(lds + PG8_SA(b, h) + aoff + m * 2048 + k * 1024); } while (0)
#define PG8_LDB(dst, b, h) do { _Pragma("unroll") for (int n = 0; n < 2; ++n) _Pragma("unroll") for (int k = 0; k < 2; ++k) dst[n][k] = *(const PG8_LAS bf16x8*)(lds + PG8_SB(b, h) + boff + n * 2048 + k * 1024); } while (0)
#define PG8_MMA(ai, bj, At, Bt) do { __builtin_amdgcn_s_setprio(1); _Pragma("unroll") for (int m = 0; m < 4; ++m) _Pragma("unroll") for (int n = 0; n < 2; ++n) _Pragma("unroll") for (int k = 0; k < 2; ++k) \
        acc[ai][bj][m][n] = __builtin_amdgcn_mfma_f32_16x16x32_bf16(Bt[n][k], At[m][k], acc[ai][bj][m][n], 0, 0, 0); __builtin_amdgcn_s_setprio(0); } while (0)
#define PG8_WAIT_V(n) asm volatile("s_waitcnt vmcnt(" #n ")" ::: "memory")
#define PG8_WAIT_L(n) asm volatile("s_waitcnt lgkmcnt(" #n ")" ::: "memory")
#define PG8_BAR __builtin_amdgcn_s_barrier()
#define PG8_SCHED __builtin_amdgcn_sched_barrier(0)
    Unit cur, nxt; int ui = 0;
    if (!S.next(0, cur)) return;
    f32x4 acc[2][2][4][2];
#pragma unroll
    for (int a = 0; a < 2; ++a)
#pragma unroll
        for (int b = 0; b < 2; ++b)
#pragma unroll
            for (int m = 0; m < 4; ++m)
#pragma unroll
                for (int n = 0; n < 2; ++n) acc[a][b][m][n] = (f32x4){0.f, 0.f, 0.f, 0.f};
    bf16x8 At[4][2], B0[2][2], B1[2][2];
    const char* cA = (const char*)g.A + (size_t)cur.pm * tstep; const char* cB = (const char*)g.Bt + (size_t)cur.pn * tstep;
    S.a_ready(cur);
    if constexpr (SP2) {
        PG8_STAGE(PG8_SB(0, 0), cB, voffB); PG8_STAGE(PG8_SB(0, 1), cB + hstep, voffB); PG8_STAGE(PG8_SA(0, 0), cA, voffA); PG8_STAGE(PG8_SA(0, 1), cA + hstep, voffA);
        if (wr == 1) PG8_BAR;
        PG8_WAIT_V(2); PG8_BAR;
        PG8_STAGE(PG8_SB(1, 0), cB + kstep, voffB); PG8_STAGE(PG8_SA(1, 0), cA + kstep, voffA); PG8_STAGE(PG8_SB(1, 1), cB + hstep + kstep, voffB);
        PG8_WAIT_V(6); PG8_BAR;
    } else {
        PG8_STAGE(PG8_SB(0, 0), cB, voffB); PG8_STAGE(PG8_SA(0, 0), cA, voffA); PG8_STAGE(PG8_SB(0, 1), cB + hstep, voffB); PG8_STAGE(PG8_SA(0, 1), cA + hstep, voffA);
        if (wr == 1) PG8_BAR;
        PG8_WAIT_V(4); PG8_BAR;
        PG8_STAGE(PG8_SB(1, 0), cB + kstep, voffB); PG8_STAGE(PG8_SA(1, 0), cA + kstep, voffA); PG8_STAGE(PG8_SB(1, 1), cB + hstep + kstep, voffB);
        PG8_WAIT_V(6); PG8_BAR;
    }
    for (;;) {
        const bool has_next = S.next(ui + 1, nxt);
        const char* nA = has_next ? (const char*)g.A + (size_t)nxt.pm * tstep : cA; const char* nB = has_next ? (const char*)g.Bt + (size_t)nxt.pn * tstep : cB;
        for (int t = 0; t < nt; t += 2) {
            const bool last = (t == nt - 2);
            const char* a1 = cA + (size_t)(t + 1) * kstep;
            const char* a2 = last ? nA : cA + (size_t)(t + 2) * kstep; const char* b2 = last ? nB : cB + (size_t)(t + 2) * kstep;
            const char* a3 = a2 + kstep; const char* b3 = b2 + kstep;
            if (last && has_next) S.a_ready(nxt);
            if constexpr (SP2) {
            PG8_LDB(B0, 0, 0); PG8_LDB(B1, 0, 1); PG8_SCHED; PG8_LDA(At, 0, 0); PG8_STAGE(PG8_SA(1, 1), a1 + hstep, voffA);
            PG8_WAIT_V(8); PG8_WAIT_L(0); PG8_BAR; PG8_MMA(0, 0, At, B0); PG8_MMA(0, 1, At, B1); PG8_BAR; PG8_SCHED;
            PG8_LDA(At, 0, 1); PG8_STAGE(PG8_SB(0, 0), b2, voffB); PG8_STAGE(PG8_SB(0, 1), b2 + hstep, voffB); PG8_STAGE(PG8_SA(0, 0), a2, voffA);
            PG8_WAIT_V(8); PG8_WAIT_L(0); PG8_BAR; PG8_MMA(1, 0, At, B0); PG8_MMA(1, 1, At, B1); PG8_BAR; PG8_SCHED;
            PG8_LDB(B0, 1, 0); PG8_LDB(B1, 1, 1); PG8_SCHED; PG8_LDA(At, 1, 0); PG8_STAGE(PG8_SA(0, 1), a2 + hstep, voffA);
            PG8_WAIT_V(8); PG8_WAIT_L(0); PG8_BAR; PG8_MMA(0, 0, At, B0); PG8_MMA(0, 1, At, B1); PG8_BAR; PG8_SCHED;
            PG8_LDA(At, 1, 1); PG8_STAGE(PG8_SB(1, 0), b3, voffB); PG8_STAGE(PG8_SB(1, 1), b3 + hstep, voffB); PG8_STAGE(PG8_SA(1, 0), a3, voffA);
            PG8_WAIT_V(8); PG8_WAIT_L(0); PG8_BAR; PG8_MMA(1, 0, At, B0); PG8_MMA(1, 1, At, B1); PG8_BAR; PG8_SCHED;
            } else {
            PG8_LDB(B0, 0, 0); PG8_SCHED; PG8_LDA(At, 0, 0); PG8_STAGE(PG8_SA(1, 1), a1 + hstep, voffA);
            PG8_WAIT_L(8); PG8_BAR; PG8_WAIT_L(0); PG8_MMA(0, 0, At, B0); PG8_BAR; PG8_SCHED;
            PG8_LDB(B1, 0, 1); PG8_STAGE(PG8_SB(0, 0), b2, voffB);
            PG8_BAR; PG8_WAIT_L(0); PG8_MMA(0, 1, At, B1); PG8_BAR;
            PG8_LDA(At, 0, 1); PG8_STAGE(PG8_SA(0, 0), a2, voffA);
            PG8_BAR; PG8_WAIT_L(0); PG8_MMA(1, 0, At, B0); PG8_BAR; PG8_SCHED;
            PG8_STAGE(PG8_SB(0, 1), b2 + hstep, voffB);
            PG8_WAIT_V(6); PG8_BAR; PG8_MMA(1, 1, At, B1); PG8_BAR;
            PG8_LDB(B0, 1, 0); PG8_SCHED; PG8_LDA(At, 1, 0); PG8_STAGE(PG8_SA(0, 1), a2 + hstep, voffA);
            PG8_WAIT_L(8); PG8_BAR; PG8_WAIT_L(0); PG8_MMA(0, 0, At, B0); PG8_BAR; PG8_SCHED;
            PG8_LDB(B1, 1, 1); PG8_STAGE(PG8_SB(1, 0), b3, voffB);
            PG8_BAR; PG8_WAIT_L(0); PG8_MMA(0, 1, At, B1); PG8_BAR;
            PG8_LDA(At, 1, 1); PG8_STAGE(PG8_SA(1, 0), a3, voffA);
            PG8_BAR; PG8_WAIT_L(0); PG8_MMA(1, 0, At, B0); PG8_BAR; PG8_SCHED;
            PG8_STAGE(PG8_SB(1, 1), b3 + hstep, voffB);
            PG8_WAIT_V(6); PG8_BAR; PG8_MMA(1, 1, At, B1); PG8_BAR;
            }
        }
        if constexpr (ALIGN_EPI) { if (wr == 0) PG8_BAR; }
        if constexpr (!Epi::AFTER_DRAIN) { E(acc, cur, wr, wc, fr, fq); S.done(cur); }
        if (!has_next) break;
#pragma unroll
        for (int a = 0; a < 2; ++a)
#pragma unroll
            for (int b = 0; b < 2; ++b)
#pragma unroll
                for (int m = 0; m < 4; ++m)
#pragma unroll
                    for (int n = 0; n < 2; ++n) acc[a][b][m][n] = (f32x4){0.f, 0.f, 0.f, 0.f};
        cur = nxt; cA = nA; cB = nB; ++ui;
        if constexpr (ALIGN_EPI) { if (wr == 1) PG8_BAR; }
    }
    PG8_WAIT_V(0);
    if constexpr (!ALIGN_EPI) { if (wr == 0) PG8_BAR; }
    PG8_BAR;
    if constexpr (Epi::AFTER_DRAIN) { E.fused(acc, cur, wr, wc, fr, fq, lds, wid, lane); S.done(cur); }
#undef PG8_SA
#undef PG8_SB
#undef PG8_STAGE
#undef PG8_LDA
#undef PG8_LDB
#undef PG8_MMA
#undef PG8_WAIT_V
#undef PG8_WAIT_L
#undef PG8_BAR
#undef PG8_SCHED
}
}

namespace sg {
using pg8::bf16_t; using pg8::bf16x8; using pg8::f32x4; using pg8::u32x4; using pg8::ssq_t;
typedef unsigned u32x2 __attribute__((ext_vector_type(2)));
constexpr int SROW0 = 32768;
template <bool GLU> __device__ __forceinline__ int brow(int tn, int ni) {
    if (GLU) { if (tn < 16) return 256 * (tn >> 2) + 32 * (tn & 3) + (ni & 1) * 16 + (ni >> 1) * 128; return 1024 + 64 * (tn - 16) + 16 * ni; }
    return 64 * tn + 16 * ni;
}
template <bool GLU, int KS, int MI, class SE>
__device__ __forceinline__ void small_gemm(PG8_LAS unsigned char* lds, const bf16_t* A, const bf16_t* Bt, int N, int K, const SE& E, int rb = 0, int re = 1 << 20) {
    int tid_ = threadIdx.x; asm volatile("" : "+v"(tid_));
    const int tid = tid_, wid = __builtin_amdgcn_readfirstlane(tid >> 6), lane = tid & 63, fr = lane & 15, fq = lane >> 4;
    constexpr int NTM = 512 / (16 * MI), RW = 2 * MI;
    const int klen = K >> 3, kbase = wid * klen, ntn = N / 64;
    const bool xm = (gridDim.x & 7) == 0;
    const int x = xm ? (blockIdx.x & 7) : 0, slot = xm ? (blockIdx.x >> 3) : blockIdx.x, nslots = xm ? (gridDim.x >> 3) : gridDim.x, tnx = xm ? (ntn >> 3) : ntn;
    for (int rnd = rb, j = slot + rb * nslots; rnd < re && j < tnx * NTM; ++rnd, j += nslots) {
        const int tn = x * tnx + j / NTM, tm = j % NTM;
        f32x4 acc[MI][4];
#pragma unroll
        for (int mi = 0; mi < MI; ++mi)
#pragma unroll
            for (int ni = 0; ni < 4; ++ni) acc[mi][ni] = (f32x4){0.f, 0.f, 0.f, 0.f};
        const bool act = (lane >> 3) < RW; const int erow = RW * wid + (lane >> 3), ej = lane & 7;
        typename SE::Pre pre = typename SE::Pre(); if (act) pre = E.pre(SROW0 + 16 * MI * tm + erow, tn, ej);
        const bf16_t* ap = A + (size_t)(SROW0 + 16 * MI * tm + fr) * K + kbase + 8 * fq;
        const bf16_t* bp[4];
#pragma unroll
        for (int ni = 0; ni < 4; ++ni) bp[ni] = Bt + (size_t)(brow<GLU>(tn, ni) + fr) * K + kbase + 8 * fq;
        for (int kc = 0; kc < klen; kc += 32 * KS) {
            bf16x8 a[KS][MI], b[KS][4];
#pragma unroll
            for (int s = 0; s < KS; ++s) {
#pragma unroll
                for (int mi = 0; mi < MI; ++mi) a[s][mi] = *(const bf16x8*)(ap + (size_t)mi * 16 * K + kc + 32 * s);
#pragma unroll
                for (int ni = 0; ni < 4; ++ni) b[s][ni] = *(const bf16x8*)(bp[ni] + kc + 32 * s);
            }
            __builtin_amdgcn_sched_barrier(0);
#pragma unroll
            for (int s = 0; s < KS; ++s)
#pragma unroll
                for (int mi = 0; mi < MI; ++mi)
#pragma unroll
                    for (int ni = 0; ni < 4; ++ni) acc[mi][ni] = __builtin_amdgcn_mfma_f32_16x16x32_bf16(b[s][ni], a[s][mi], acc[mi][ni], 0, 0, 0);
            __builtin_amdgcn_sched_barrier(0);
        }
        PG8_LAS unsigned char* mine = lds + wid * 16384;
#pragma unroll
        for (int mi = 0; mi < MI; ++mi)
#pragma unroll
            for (int ni = 0; ni < 4; ++ni) { const int row = 16 * mi + fr, ch = 4 * ni + fq; *(PG8_LAS f32x4*)(mine + row * 256 + ((ch ^ (row & 15)) << 4)) = acc[mi][ni]; }
        __syncthreads();
        if (act) {
            const int row = erow, j8 = ej;
            const bool glu = GLU && tn < 16;
            const int c0 = glu ? j8 : 2 * j8, c1 = glu ? 8 + j8 : 2 * j8 + 1;
            f32x4 v0 = (f32x4){0.f, 0.f, 0.f, 0.f}, v1 = v0;
#pragma unroll
            for (int p = 0; p < 8; ++p) { v0 += *(const PG8_LAS f32x4*)(lds + p * 16384 + row * 256 + ((c0 ^ (row & 15)) << 4)); v1 += *(const PG8_LAS f32x4*)(lds + p * 16384 + row * 256 + ((c1 ^ (row & 15)) << 4)); }
            E(SROW0 + 16 * MI * tm + row, tn, j8, v0, v1, pre);
        }
        __syncthreads();
    }
    asm volatile("s_waitcnt vmcnt(0)" ::: "memory");
    __syncthreads();
}
using pg8::sumsq8; using pg8::unpack8;
__device__ __forceinline__ float red8(float s) { s += __shfl_xor(s, 1); s += __shfl_xor(s, 2); s += __shfl_xor(s, 4); return s; }
struct SGlu { bf16_t* C; bf16_t* U; const ssq_t* ssq; typedef ssq_t Pre;
    __device__ __forceinline__ Pre pre(int r, int, int) const { return ssq[r]; }
    __device__ __forceinline__ void operator()(int r, int tn, int j, const f32x4 v0, const f32x4 v1, const Pre& p) const { const float rsv = pg8::rs_from(p);
        if (tn < 16) { const int ch0 = 128 * (tn >> 2) + 32 * (tn & 3) + 4 * j; float c[4];
#pragma unroll
            for (int i = 0; i < 4; ++i) c[i] = (v0[i] * rsv) * pg8::sigm(v1[i] * rsv);
            u32x2 w; w.x = pg8::cvt_pk_bf16(c[0], c[1]); w.y = pg8::cvt_pk_bf16(c[2], c[3]); *(u32x2*)(C + (size_t)r * 512 + ch0) = w; }
        else *(u32x4*)(U + (size_t)r * 512 + 64 * (tn - 16) + 8 * j) = pg8::pack8(v0 * rsv, v1 * rsv); } };
struct SRes { const bf16_t* base; bf16_t* XB; ssq_t* ssq_out; typedef u32x4 Pre;
    __device__ __forceinline__ Pre pre(int r, int tn, int j) const { return *(const u32x4*)(base + (size_t)r * 1024 + 64 * tn + 8 * j); }
    __device__ __forceinline__ void operator()(int r, int tn, int j, const f32x4 v0, const f32x4 v1, const Pre& p) const { const size_t off = (size_t)r * 1024 + 64 * tn + 8 * j;
        f32x4 b0, b1; unpack8(p, b0, b1); const u32x4 w = pg8::pack8(b0 + v0, b1 + v1); *(u32x4*)(XB + off) = w; unpack8(w, b0, b1);
        const float ss = red8(sumsq8(b0, b1)); if (j == 0) pg8::ssq_add(ssq_out + r, ss); } };
struct SRelu2 { bf16_t* H; const ssq_t* ssq; typedef ssq_t Pre;
    __device__ __forceinline__ Pre pre(int r, int, int) const { return ssq[r]; }
    __device__ __forceinline__ void operator()(int r, int tn, int j, f32x4 v0, f32x4 v1, const Pre& p) const { const float rsv = pg8::rs_from(p); v0 = v0 * rsv; v1 = v1 * rsv;
#pragma unroll
        for (int i = 0; i < 4; ++i) { v0[i] = fmaxf(v0[i], 0.f); v1[i] = fmaxf(v1[i], 0.f); }
        *(u32x4*)(H + (size_t)r * 4096 + 64 * tn + 8 * j) = pg8::pack8(v0 * v0, v1 * v1); } };
struct SQ { bf16_t* Q; typedef int Pre;
    __device__ __forceinline__ Pre pre(int, int, int) const { return 0; }
    __device__ __forceinline__ void operator()(int r, int tn, int j, const f32x4 v0, const f32x4 v1, const Pre&) const { *(u32x4*)(Q + (size_t)r * 1024 + 64 * tn + 8 * j) = pg8::pack8(v0, v1); } };
struct SGate { const bf16_t* Q; const bf16_t* XBin; bf16_t* XBout; const ssq_t* ssq; ssq_t* ssq_out;
    struct Pre { u32x4 q, x; ssq_t s; };
    __device__ __forceinline__ Pre pre(int r, int tn, int j) const { const size_t off = (size_t)r * 1024 + 64 * tn + 8 * j; Pre p; p.q = *(const u32x4*)(Q + off); p.x = *(const u32x4*)(XBin + off); p.s = ssq[r]; return p; }
    __device__ __forceinline__ void operator()(int r, int tn, int j, const f32x4 v0, const f32x4 v1, const Pre& p) const { const float rsv = pg8::rs_from(p.s); const size_t off = (size_t)r * 1024 + 64 * tn + 8 * j;
        f32x4 q0, q1, x0, x1; unpack8(p.q, q0, q1); unpack8(p.x, x0, x1);
        f32x4 o0, o1;
#pragma unroll
        for (int i = 0; i < 4; ++i) { o0[i] = x0[i] + pg8::sigm(v0[i] * rsv) * q0[i]; o1[i] = x1[i] + pg8::sigm(v1[i] * rsv) * q1[i]; }
        const u32x4 w = pg8::pack8(o0, o1); *(u32x4*)(XBout + off) = w; unpack8(w, o0, o1);
        const float ss = red8(sumsq8(o0, o1)); if (j == 0) pg8::ssq_add(ssq_out + r, ss); } };
}

constexpr int NWAVES = 8, NTHR = 512;
constexpr int DM = 1024, MP = 32768, MS = 512, MT = MP + MS, DEPTH = 4, DCONV = 512, DPOOL = 512, NIN = 1536, DFF = 4096, PLE = 256, SEQ = 4096, DSEQ = 64, NB = 8, CW = 31, HC = 30, HP = 15, PAST = 2048;
static_assert(MP == pg8::E_MP, "prompt rows");
constexpr size_t MiB = 1u << 20;
constexpr size_t WS_CTL = 0, CTL_ZERO_BYTES = 65536;
constexpr size_t WS_HIST = 1 * MiB;
constexpr size_t WS_SSQ = 3 * MiB;
constexpr size_t WS_W = 7 * MiB;
constexpr size_t WL_IN = 0, WL_OUT = 3 * MiB, WL_FF1 = 5 * MiB, WL_FF2 = 13 * MiB, WL_GATE = 21 * MiB, WL_PLE = 23 * MiB, WL_STRIDE = 23 * MiB + MiB / 2;
constexpr size_t WS_XB = 101 * MiB;
constexpr size_t WS_PB = 166 * MiB;
constexpr size_t WS_R = 231 * MiB;
constexpr size_t R_C = 0, R_U = (size_t)MT * 512 * 2, R_MIX = 2 * R_U, R_Q = R_MIX + (size_t)MT * 1024 * 2, R_XA = R_Q + (size_t)MT * 1024 * 2;
constexpr size_t WS_END = WS_R + (size_t)MT * 4096 * 2;
constexpr size_t H_CH = 0, H_UH = (size_t)4 * 8 * 30 * 512 * 2;
static_assert(WS_HIST + H_UH + (size_t)4 * 8 * 15 * 512 * 2 <= WS_SSQ && WS_SSQ + (size_t)13 * MT * 8 <= WS_W && WS_W + DEPTH * WL_STRIDE <= WS_XB && WS_XB + (size_t)MT * 2048 <= WS_PB && WS_PB + (size_t)DEPTH * MT * 512 <= WS_R && R_XA + (size_t)MT * 2048 <= (size_t)MT * 8192 && WS_END <= 512 * MiB, "d_ws map");
constexpr size_t OUT_Y = 0, OUT_NCP = (size_t)MT * DM, OUT_NPP = OUT_NCP + (size_t)DEPTH * NB * HC * DCONV, OUT_NCS = OUT_NPP + (size_t)DEPTH * NB * HP * DPOOL, OUT_NPS = OUT_NCS + (size_t)DEPTH * NB * HC * DCONV, OUT_END = OUT_NPS + (size_t)DEPTH * NB * HP * DPOOL;
constexpr int LDS_BYTES = 147456;
constexpr int MISC_OFF = 131072 + 320;

#define LAS __attribute__((address_space(3)))
typedef unsigned short bf16;
typedef unsigned v4u __attribute__((ext_vector_type(4)));
typedef unsigned v2u __attribute__((ext_vector_type(2)));
typedef float f32x4 __attribute__((ext_vector_type(4)));
#define LDS_WAIT() asm volatile("s_waitcnt lgkmcnt(0)" ::: "memory")
__device__ __forceinline__ unsigned pk2(float lo, float hi) { return pg8::cvt_pk_bf16(lo, hi); }
__device__ __forceinline__ float bf_lo(unsigned w) { return __uint_as_float(w << 16); }
__device__ __forceinline__ float bf_hi(unsigned w) { return __uint_as_float(w & 0xffff0000u); }
__device__ __forceinline__ float wave_sum(float v) {
#pragma unroll
    for (int o = 1; o < 64; o <<= 1) v += __shfl_xor(v, o);
    return v;
}

struct Args { const float* in[22]; float* out; unsigned char* ws; };
enum { I_XP = 0, I_XS, I_PP, I_PS, I_CC, I_CP, I_WIN, I_CONVW, I_CONVB, I_LNG, I_LNB, I_POOLW, I_PSCALE, I_WOUT, I_GMIX, I_GFFN, I_GPLE, I_WFF1, I_WFF2, I_WPLE, I_WGATE, I_GFINAL };

struct TrDesc { const float* W; const float* g; bf16* WT; int ldw, k0, n0, ldd, drow0; };
__device__ __forceinline__ void tr_load(const TrDesc& d, float (&v)[32], int lane) {
#pragma unroll
    for (int i = 0; i < 32; ++i) v[i] = d.W[(size_t)(d.k0 + 2 * i + (lane >> 5)) * d.ldw + d.n0 + (lane & 31)];
}
__device__ __forceinline__ void tr_store(const TrDesc& d, const float (&v)[32], LAS float* scr, int lane) {
#pragma unroll
    for (int i = 0; i < 32; ++i) scr[(2 * i + (lane >> 5)) * 33 + (lane & 31)] = v[i];
    const int c = lane & 7;
    f32x4 g0 = (f32x4){1.f, 1.f, 1.f, 1.f}, g1 = g0;
    if (d.g) { g0 = *(const f32x4*)(d.g + d.k0 + 8 * c); g1 = *(const f32x4*)(d.g + d.k0 + 8 * c + 4); }
    LDS_WAIT(); asm volatile("" ::: "memory");
#pragma unroll
    for (int j = 0; j < 4; ++j) { const int n = (lane >> 3) + 8 * j; const LAS float* s = scr + (8 * c) * 33 + n;
        v4u o; o.x = pk2(s[0 * 33] * g0[0], s[1 * 33] * g0[1]); o.y = pk2(s[2 * 33] * g0[2], s[3 * 33] * g0[3]); o.z = pk2(s[4 * 33] * g1[0], s[5 * 33] * g1[1]); o.w = pk2(s[6 * 33] * g1[2], s[7 * 33] * g1[3]);
        *(v4u*)(d.WT + (size_t)(d.drow0 + n) * d.ldd + d.k0 + 8 * c) = o; }
    LDS_WAIT(); asm volatile("" ::: "memory");
}
__device__ __forceinline__ int win_row(int n) { return n < 512 ? ((n >> 7) * 256 + (n & 127)) : (n < 1024 ? (((n - 512) >> 7) * 256 + 128 + (n & 127)) : n); }

__device__ __forceinline__ void prologue(const Args& a, LAS unsigned char* lds) {
    int tid_ = threadIdx.x; asm volatile("" : "+v"(tid_));
    const int tid = tid_, lane = tid & 63, wave = __builtin_amdgcn_readfirstlane(tid >> 6);
    const int G = gridDim.x, gw = blockIdx.x * NWAVES + wave, NGW = G * NWAVES;
    const size_t gt = (size_t)blockIdx.x * NTHR + tid, NGT = (size_t)G * NTHR;
    unsigned char* ws = a.ws;
    LAS float* scr = (LAS float*)(lds + wave * 16384);
    constexpr int IT_IN = 16 * 48, IT_OUT = 8 * 32, IT_FF1 = 16 * 128, IT_FF2 = 64 * 32, IT_GATE = 16 * 32, IT_PLE = 4 * 32, IT_L = IT_IN + IT_OUT + IT_FF1 + IT_FF2 + IT_GATE + IT_PLE;
#ifndef REP_T
#define REP_T 1
#endif
#ifndef REP_X
#define REP_X 1
#endif
    auto desc = [&](int it) -> TrDesc {
        const int l = it / IT_L; int r = it - l * IT_L; unsigned char* wl = ws + WS_W + (size_t)l * WL_STRIDE; TrDesc d;
        if (r < IT_IN) { const int kb = r / 48, nb = r % 48; d = TrDesc{a.in[I_WIN] + (size_t)l * DM * NIN, a.in[I_GMIX] + l * DM, (bf16*)(wl + WL_IN), NIN, 64 * kb, 32 * nb, DM, win_row(32 * nb)}; return d; } r -= IT_IN;
        if (r < IT_OUT) { const int kb = r / 32, nb = r % 32; d = TrDesc{a.in[I_WOUT] + (size_t)l * DM * DM, nullptr, (bf16*)(wl + WL_OUT), DM, 64 * kb, 32 * nb, DM, 32 * nb}; return d; } r -= IT_OUT;
        if (r < IT_FF1) { const int kb = r / 128, nb = r % 128; d = TrDesc{a.in[I_WFF1] + (size_t)l * DM * DFF, a.in[I_GFFN] + l * DM, (bf16*)(wl + WL_FF1), DFF, 64 * kb, 32 * nb, DM, 32 * nb}; return d; } r -= IT_FF1;
        if (r < IT_FF2) { const int kb = r / 32, nb = r % 32; d = TrDesc{a.in[I_WFF2] + (size_t)l * DFF * DM, nullptr, (bf16*)(wl + WL_FF2), DM, 64 * kb, 32 * nb, DFF, 32 * nb}; return d; } r -= IT_FF2;
        if (r < IT_GATE) { const int kb = r / 32, nb = r % 32; d = TrDesc{a.in[I_WGATE] + (size_t)l * DM * DM, a.in[I_GPLE] + l * DM, (bf16*)(wl + WL_GATE), DM, 64 * kb, 32 * nb, DM, 32 * nb}; return d; } r -= IT_GATE;
        { const int kb = r / 32, nb = r % 32; d = TrDesc{a.in[I_WPLE] + (size_t)l * PLE * DM, nullptr, (bf16*)(wl + WL_PLE), DM, 64 * kb, 32 * nb, PLE, 32 * nb}; return d; }
    };
    for (int rep = 0; rep < REP_T; ++rep)
    for (int it = gw; it < DEPTH * IT_L; it += 2 * NGW) {
        const bool two = it + NGW < DEPTH * IT_L;
        const TrDesc dA = desc(it), dB = desc(two ? it + NGW : it);
        float vA[32], vB[32];
        tr_load(dA, vA, lane); if (two) tr_load(dB, vB, lane);
        tr_store(dA, vA, scr, lane); if (two) tr_store(dB, vB, scr, lane);
    }
    for (size_t w = gt; w < (size_t)DEPTH * 4 * 16 * 256; w += NGT) {
        const int n4 = (int)(w & 255); const int hi = __builtin_amdgcn_readfirstlane((int)(w >> 8)); const int cb = hi & 15, g = (hi >> 4) & 3, l = hi >> 6;
        const float* wo = a.in[I_WOUT] + (size_t)l * DM * DM + (size_t)(512 + 128 * g) * DM + 4 * n4; const float* sc = a.in[I_PSCALE] + l * DPOOL + 128 * g;
        const float* pw = a.in[I_POOLW] + ((size_t)(l * 4 + g) * 128 + 8 * cb) * 128;
        f32x4 acc[8];
#pragma unroll
        for (int j = 0; j < 8; ++j) acc[j] = (f32x4){0.f, 0.f, 0.f, 0.f};
#pragma unroll 8
        for (int d = 0; d < 128; ++d) { const f32x4 wv = *(const f32x4*)(wo + (size_t)d * DM) * sc[d];
#pragma unroll
            for (int j = 0; j < 8; ++j) acc[j] += wv * pw[j * 128 + d]; }
        bf16* dst = (bf16*)(ws + WS_W + (size_t)l * WL_STRIDE + WL_OUT) + (size_t)(4 * n4) * DM + 512 + 128 * g + 8 * cb;
#pragma unroll
        for (int i = 0; i < 4; ++i) { v4u o; o.x = pk2(acc[0][i], acc[1][i]); o.y = pk2(acc[2][i], acc[3][i]); o.z = pk2(acc[4][i], acc[5][i]); o.w = pk2(acc[6][i], acc[7][i]); *(v4u*)(dst + (size_t)i * DM) = o; }
    }
    for (int rep = 0; rep < REP_X; ++rep) {
    pg8::ssq_t* ssq = (pg8::ssq_t*)(ws + WS_SSQ);
    for (int r0 = gw; r0 < MT; r0 += 2 * NGW) {
        f32x4 v[2][4];
#pragma unroll
        for (int u = 0; u < 2; ++u) { const int r = r0 + u * NGW; if (r < MT) { const float* xr = (r < MP) ? a.in[I_XP] + (size_t)r * DM : a.in[I_XS] + (size_t)(r - MP) * DM;
#pragma unroll
            for (int j = 0; j < 4; ++j) v[u][j] = *((const f32x4*)xr + lane + 64 * j); } }
#pragma unroll
        for (int u = 0; u < 2; ++u) { const int r = r0 + u * NGW; if (r < MT) { bf16* o = (bf16*)(ws + WS_R + R_XA) + (size_t)r * DM; float s = 0.f;
#pragma unroll
            for (int j = 0; j < 4; ++j) { const f32x4 t = v[u][j]; s += (t[0] * t[0] + t[1] * t[1]) + (t[2] * t[2] + t[3] * t[3]);
                v2u p; p.x = pk2(t[0], t[1]); p.y = pk2(t[2], t[3]); *((v2u*)o + lane + 64 * j) = p; }
            s = wave_sum(s); if (lane == 0) ssq[r] = (pg8::ssq_t)(s * 1048576.0f); } }
    }
    for (size_t i = gt; i < (size_t)12 * MT; i += NGT) ssq[MT + i] = 0ull;
    for (size_t i = gt; i < (size_t)DEPTH * NB * (HC + HP) * 256; i += NGT) {
        const size_t nc = (size_t)DEPTH * NB * HC * 256;
        if (i < nc) { const float* s = a.in[I_CC] + 2 * i; *((unsigned*)(ws + WS_HIST + H_CH) + i) = pk2(s[0], s[1]); }
        else { const size_t k = i - nc; const float* s = a.in[I_CP] + 2 * k; *((unsigned*)(ws + WS_HIST + H_UH) + k) = pk2(s[0], s[1]); }
    }
    constexpr size_t NPI = (size_t)DEPTH * MT * (PLE / 8);
    for (size_t i0 = gt; i0 < NPI; i0 += 4 * NGT) {
        f32x4 v0[4], v1[4];
#pragma unroll
        for (int u = 0; u < 4; ++u) { const size_t i = i0 + u * NGT; if (i < NPI) {
            const int c8 = (int)(i & 31); const size_t lr = i >> 5; const int l = (int)(lr / MT), r = (int)(lr % MT);
            const float* src = (r < MP) ? a.in[I_PP] + ((size_t)l * MP + r) * PLE : a.in[I_PS] + ((size_t)l * MS + (r - MP)) * PLE;
            v0[u] = *((const f32x4*)src + 2 * c8); v1[u] = *((const f32x4*)src + 2 * c8 + 1); } }
#pragma unroll
        for (int u = 0; u < 4; ++u) { const size_t i = i0 + u * NGT; if (i < NPI) {
            v4u o; o.x = pk2(v0[u][0], v0[u][1]); o.y = pk2(v0[u][2], v0[u][3]); o.z = pk2(v1[u][0], v1[u][1]); o.w = pk2(v1[u][2], v1[u][3]);
            *((v4u*)(ws + WS_PB) + i) = o; } }
    }
    }
}

typedef float f32x2 __attribute__((ext_vector_type(2)));
template <int CTRL> __device__ __forceinline__ float dpp_mov(float v) { return __builtin_bit_cast(float, __builtin_amdgcn_update_dpp(0, __builtin_bit_cast(int, v), CTRL, 0xF, 0xF, true)); }
__device__ __forceinline__ float row16_sum(float v) {
    v += dpp_mov<0xB1>(v); v += dpp_mov<0x4E>(v); v += dpp_mov<0x141>(v); v += dpp_mov<0x140>(v); return v;
}
template <int W, int R> __device__ __forceinline__ void pool_load(unsigned (&pk)[31], const bf16* U, const bf16* hist, bool samp, int seqbase, int tb, int cp) {
#pragma unroll
    for (int j = 0; j < W + R - 1; ++j) { const int t = tb - (W - 1) + j;
        const bf16* src = t >= 0 ? U + (size_t)(seqbase + t) * 512 : (samp ? hist + (size_t)(HP + t) * DPOOL : U);
        pk[j] = *(const unsigned*)(src + 2 * cp); }
}
template <int W, int R> __device__ __forceinline__ void pool_rows(const unsigned (&pk)[31], bool samp, int tb, int pos0, bf16* mixrow) {
    f32x2 a[W + R - 1];
#pragma unroll
    for (int j = 0; j < W + R - 1; ++j) { const int t = tb - (W - 1) + j; const bool valid = (t >= 0) || samp; a[j] = valid ? (f32x2){bf_lo(pk[j]), bf_hi(pk[j])} : (f32x2){0.f, 0.f}; }
    f32x2 s = (f32x2){0.f, 0.f};
#pragma unroll
    for (int k = 0; k < W; ++k) s += a[k];
#pragma unroll
    for (int i = 0; i < R; ++i) {
        if (i > 0) { if (W >= 8) { s += a[i + W - 1]; s -= a[i - 1]; }
                     else { s = (f32x2){0.f, 0.f};
#pragma unroll
                            for (int k = 0; k < W; ++k) s += a[i + k]; } }
        const int pos = pos0 + tb + i; const float inv = 1.0f / (float)(pos + 1 < W ? pos + 1 : W);
        *(unsigned*)(mixrow + (size_t)i * 1024) = pk2(s.x * inv - a[i + W - 1].x, s.y * inv - a[i + W - 1].y); }
}
template <int R> __device__ __forceinline__ void pb_item(int r0, bool samp, int l, const bf16* C, const bf16* U, bf16* MIX, const unsigned char* ws, const LAS f32x2* wl, f32x2 cb, f32x2 lg, f32x2 lb,
                                                         LAS f32x2* red, LAS f32x2* st, int tid, int lane, int half, int wq, int cp) {
    int b, t0, seqbase; if (!samp) { b = r0 >> 12; t0 = r0 & 4095; seqbase = b << 12; } else { const int rr = r0 - MP; b = rr >> 6; t0 = rr & 63; seqbase = MP + (b << 6); }
    const int tb = t0 + R * half, pos0 = samp ? PAST : 0;
    const bf16* chist = (const bf16*)(ws + WS_HIST + H_CH) + (size_t)(l * NB + b) * HC * DCONV;
    const bf16* uhist = (const bf16*)(ws + WS_HIST + H_UH) + (size_t)(l * NB + b) * HP * DPOOL;
    unsigned pk[R + 30];
#pragma unroll
    for (int j = 0; j < R + 30; ++j) { const int t = tb - HC + j;
        const bf16* src = t >= 0 ? C + (size_t)(seqbase + t) * 512 : (samp ? chist + (size_t)(HC + t) * DCONV : C);
        pk[j] = *(const unsigned*)(src + 2 * cp); }
    unsigned pp[31];
    if (wq == 0) pool_load<2, R>(pp, U, uhist, samp, seqbase, tb, cp); else if (wq == 1) pool_load<4, R>(pp, U, uhist, samp, seqbase, tb, cp);
    else if (wq == 2) pool_load<8, R>(pp, U, uhist, samp, seqbase, tb, cp); else pool_load<16, R>(pp, U, uhist, samp, seqbase, tb, cp);
    f32x2 o[R];
    { f32x2 w[CW];
#pragma unroll
      for (int k = 0; k < CW; ++k) w[k] = wl[k * 256 + cp];
#pragma unroll
      for (int i = 0; i < R; ++i) o[i] = cb;
#pragma unroll
      for (int j = 0; j < R + 30; ++j) { const int t = tb - HC + j; const bool valid = (t >= 0) || samp;
          const f32x2 v = valid ? (f32x2){bf_lo(pk[j]), bf_hi(pk[j])} : (f32x2){0.f, 0.f};
#pragma unroll
          for (int i = 0; i < R; ++i) { const int k = j - i; if (k >= 0 && k < CW) o[i] += w[k] * v; } } }
#pragma unroll
    for (int i = 0; i < R; ++i) { const float s = row16_sum(o[i].x + o[i].y), q = row16_sum(o[i].x * o[i].x + o[i].y * o[i].y);
        if ((lane & 15) == 0) red[(half * R + i) * 16 + wq * 4 + (lane >> 4)] = (f32x2){s, q}; }
    __syncthreads();
    if (tid < 2 * R) { float s = 0.f, q = 0.f;
#pragma unroll
        for (int k = 0; k < 16; ++k) { const f32x2 p = red[tid * 16 + k]; s += p.x; q += p.y; }
        const float mean = s * (1.0f / DCONV), var = q * (1.0f / DCONV) - mean * mean; st[tid] = (f32x2){mean, rsqrtf(fmaxf(var, 0.f) + 1e-6f)}; }
    __syncthreads();
    bf16* mrow = MIX + (size_t)(r0 + R * half) * 1024 + 2 * cp;
#pragma unroll
    for (int i = 0; i < R; ++i) { const f32x2 ms = st[half * R + i];
        float y0 = (o[i].x - ms.x) * ms.y * lg.x + lb.x, y1 = (o[i].y - ms.x) * ms.y * lg.y + lb.y; y0 *= pg8::sigm(y0); y1 *= pg8::sigm(y1);
        *(unsigned*)(mrow + (size_t)i * 1024) = pk2(y0, y1); }
    bf16* prow = mrow + 512;
    if (wq == 0) pool_rows<2, R>(pp, samp, tb, pos0, prow); else if (wq == 1) pool_rows<4, R>(pp, samp, tb, pos0, prow);
    else if (wq == 2) pool_rows<8, R>(pp, samp, tb, pos0, prow); else pool_rows<16, R>(pp, samp, tb, pos0, prow);
}

__device__ __forceinline__ void phase_b(const Args& a, int l, LAS unsigned char* lds) {
    int tid_ = threadIdx.x; asm volatile("" : "+v"(tid_));
    const int tid = tid_, lane = tid & 63, wave = __builtin_amdgcn_readfirstlane(tid >> 6), half = wave >> 2, wq = wave & 3, cp = wq * 64 + lane;
    unsigned char* ws = a.ws;
    const bf16* C = (const bf16*)(ws + WS_R + R_C); const bf16* U = (const bf16*)(ws + WS_R + R_U); bf16* MIX = (bf16*)(ws + WS_R + R_MIX);
    LAS f32x2* red = (LAS f32x2*)lds;
    LAS f32x2* st = (LAS f32x2*)(lds + 4096);
    LAS f32x2* wl = (LAS f32x2*)(lds + 8192);
    { const f32x2* cw = (const f32x2*)(a.in[I_CONVW] + (size_t)l * CW * DCONV);
      for (int i = tid; i < CW * 256; i += NTHR) wl[i] = cw[i];
      __syncthreads(); }
    const f32x2 cb = *(const f32x2*)(a.in[I_CONVB] + l * DCONV + 2 * cp), lg = *(const f32x2*)(a.in[I_LNG] + l * DCONV + 2 * cp), lb = *(const f32x2*)(a.in[I_LNB] + l * DCONV + 2 * cp);
    for (int ib = blockIdx.x; ib < MP / 32; ib += gridDim.x) pb_item<16>(ib * 32, false, l, C, U, MIX, ws, wl, cb, lg, lb, red, st, tid, lane, half, wq, cp);
    for (int jb = blockIdx.x; jb < MS / 2; jb += gridDim.x) pb_item<1>(MP + jb * 2, true, l, C, U, MIX, ws, wl, cb, lg, lb, red, st, tid, lane, half, wq, cp);
    const size_t gt = (size_t)blockIdx.x * NTHR + tid, NGT = (size_t)gridDim.x * NTHR;
    constexpr int NC = NB * HC * DCONV, NPL = NB * HP * DPOOL;
    for (size_t i = gt; i < (size_t)2 * (NC + NPL); i += NGT) { int r = (int)i; float* out = a.out;
        if (r < NC) { const int ch = r & 511, j = (r >> 9) % HC, b = (r >> 9) / HC; out[OUT_NCP + (size_t)l * NC + r] = bf_lo(C[((size_t)b * SEQ + SEQ - HC + j) * 512 + ch]); continue; } r -= NC;
        if (r < NPL) { const int ch = r & 511, j = (r >> 9) % HP, b = (r >> 9) / HP; out[OUT_NPP + (size_t)l * NPL + r] = bf_lo(U[((size_t)b * SEQ + SEQ - HP + j) * 512 + ch]); continue; } r -= NPL;
        if (r < NC) { const int ch = r & 511, j = (r >> 9) % HC, b = (r >> 9) / HC; out[OUT_NCS + (size_t)l * NC + r] = bf_lo(C[((size_t)MP + b * DSEQ + DSEQ - HC + j) * 512 + ch]); continue; } r -= NC;
        { const int ch = r & 511, j = (r >> 9) % HP, b = (r >> 9) / HP; out[OUT_NPS + (size_t)l * NPL + r] = bf_lo(U[((size_t)MP + b * DSEQ + DSEQ - HP + j) * 512 + ch]); }
    }
}

#define XB_TMO      128
#define XB_XCNT(j)  (256  + 64 * (j))
#define XB_XSUB(j)  (1280 + 64 * (j))
#define XB_XGEN(j)  (2304 + 64 * (j))
#define XB_TOP      3328
#define XB_TOPGEN   3392
#define XCD_BAR_WORDS 3456
#define XB_SPIN_CAP (1u << 18)

__device__ __forceinline__ unsigned xb_ld(unsigned* p)              { return __hip_atomic_load(p, __ATOMIC_RELAXED, __HIP_MEMORY_SCOPE_AGENT); }
__device__ __forceinline__ unsigned xb_add(unsigned* p, unsigned v) { return __hip_atomic_fetch_add(p, v, __ATOMIC_RELAXED, __HIP_MEMORY_SCOPE_AGENT); }
__device__ __forceinline__ unsigned xb_xcc_id() { return (unsigned)__builtin_amdgcn_s_getreg((3 << 11) | 20) & 0xFu; }
#define XB_SPIN(cond, bar) do { unsigned _sp = 0; while (cond) { __builtin_amdgcn_s_sleep(1); \
    if ((++_sp & 255u) == 0u) { if (xb_ld(&(bar)[XB_TMO])) break; if (_sp > XB_SPIN_CAP) { atomicAdd(&(bar)[XB_TMO], 1u); break; } } } } while (0)

struct XcdBarrier {
    unsigned* bar; unsigned x;
    volatile LAS unsigned* st;
};

__device__ __forceinline__ XcdBarrier xcd_barrier_post(unsigned* bar, volatile LAS unsigned* st) {
    XcdBarrier b; b.bar = bar; b.x = xb_xcc_id(); b.st = st;
    if (threadIdx.x == 0) (void)xb_add(&bar[XB_XCNT(b.x)], 1u);
    return b;
}
__device__ __forceinline__ void xcd_barrier_complete(unsigned* bar, unsigned x, unsigned& nloc, unsigned& nx) {
    const unsigned G = gridDim.x * gridDim.y * gridDim.z;
    unsigned sum, cnt, mine, sp = 0u;
    for (;;) {
        sum = 0u; cnt = 0u; mine = 0u;
#pragma unroll
        for (unsigned j = 0; j < 16; ++j) { const unsigned c = xb_ld(&bar[XB_XCNT(j)]); sum += c; cnt += (c > 0u) ? 1u : 0u; mine = (j == x) ? c : mine; }
        if (sum == G) break;
        __builtin_amdgcn_s_sleep(1);
        if ((++sp & 255u) == 0u) { if (xb_ld(&bar[XB_TMO])) break; if (sp > XB_SPIN_CAP) { atomicAdd(&bar[XB_TMO], 1u); break; } }
    }
    nloc = mine > 0u ? mine : 1u; nx = cnt > 0u ? cnt : 1u;
}

__device__ __forceinline__ void xcd_barrier(const XcdBarrier& b) {
    asm volatile("s_waitcnt vmcnt(0)" ::: "memory");
    __syncthreads();
    if (threadIdx.x == 0) {
        unsigned* bar = b.bar;
        __builtin_amdgcn_s_waitcnt(0);
        unsigned nloc = b.st[0], nx = b.st[1];
        if (nloc == 0u) { xcd_barrier_complete(bar, b.x, nloc, nx); b.st[0] = nloc; b.st[1] = nx; }
        const unsigned old = xb_add(&bar[XB_XSUB(b.x)], 1u);
        const unsigned gen = old / nloc;
        if (old + 1u == (gen + 1u) * nloc) {
            __builtin_amdgcn_fence(__ATOMIC_RELEASE, "agent");
            asm volatile("s_waitcnt vmcnt(0)" ::: "memory");
            const unsigned og = xb_add(&bar[XB_TOP], 1u);
            const unsigned tg = og / nx;
            if (og + 1u == (tg + 1u) * nx) xb_add(&bar[XB_TOPGEN], 1u);
            else XB_SPIN(xb_ld(&bar[XB_TOPGEN]) == tg, bar);
            __builtin_amdgcn_fence(__ATOMIC_ACQUIRE, "agent");
            xb_add(&bar[XB_XGEN(b.x)], 1u);
            asm volatile("s_waitcnt vmcnt(0)" ::: "memory");
        } else {
            XB_SPIN(xb_ld(&bar[XB_XGEN(b.x)]) == gen, bar);
            __builtin_amdgcn_fence(__ATOMIC_ACQUIRE, "agent");
            asm volatile("s_waitcnt vmcnt(0)" ::: "memory");
        }
    }
    __syncthreads();
}

__global__ void __launch_bounds__(NTHR, 2) mk_fwd(Args a) {
    extern __shared__ __attribute__((aligned(16))) unsigned char lds_raw[];
    LAS unsigned char* lds = (LAS unsigned char*)lds_raw;
    cg::grid_group grid = cg::this_grid();
    volatile LAS unsigned* MISC = (volatile LAS unsigned*)(lds + MISC_OFF);
    if (threadIdx.x < 32) MISC[threadIdx.x] = 0u;
    __syncthreads();
    const XcdBarrier bar = xcd_barrier_post((unsigned*)(a.ws + WS_CTL), MISC + 8);
#define GRID_BAR() xcd_barrier(bar)
    unsigned char* ws = a.ws;
    pg8::ssq_t* ssq = (pg8::ssq_t*)(ws + WS_SSQ); float* X = a.out;
    bf16* XB = (bf16*)(ws + WS_XB); bf16* XA = (bf16*)(ws + WS_R + R_XA);
    bf16* Cb = (bf16*)(ws + WS_R + R_C); bf16* Ub = (bf16*)(ws + WS_R + R_U); bf16* MIX = (bf16*)(ws + WS_R + R_MIX); bf16* Qb = (bf16*)(ws + WS_R + R_Q); bf16* Hb = (bf16*)(ws + WS_R);
    const int G = gridDim.x, c = blockIdx.x;
#ifndef REP_B
#define REP_B 1
#endif
#ifndef REP_D
#define REP_D 1
#endif
#ifndef REP_S
#define REP_S 1
#endif
    prologue(a, lds);
    asm volatile("s_waitcnt vmcnt(0) lgkmcnt(0)" ::: "memory"); __syncthreads();
    grid.sync();
    __builtin_amdgcn_fence(__ATOMIC_ACQUIRE, "agent"); asm volatile("s_waitcnt vmcnt(0)" ::: "memory"); __syncthreads();
    const int alt = c & 1, cls3 = (c & 7) % 3;
#pragma unroll 1
    for (int l = 0; l < DEPTH; ++l) {
        const unsigned char* wl = ws + WS_W + (size_t)l * WL_STRIDE;
#pragma unroll 1
        for (int st = 0; st < 2; ++st) {
            if ((st ^ alt) == 0) { pg8::Gemm g{XA, (const bf16*)(wl + WL_IN), MT, NIN, DM}; pg8::StaticOrder S; S.init(MP, NIN, G, c);
                pg8::EpiGLU E{Cb, Ub, ssq + (size_t)(3 * l) * MT};
                pg8::gemm_phase<pg8::EpiGLU, pg8::StaticOrder, true, true>(lds, g, S, E); }
            else { sg::SGlu SE{Cb, Ub, ssq + (size_t)(3 * l) * MT}; sg::small_gemm<true, 4, 4, sg::SGlu>(lds, XA, (const bf16*)(wl + WL_IN), NIN, DM, SE); } }
        GRID_BAR();
        phase_b(a, l, lds);
        GRID_BAR();
#pragma unroll 1
        for (int st = 0; st < 2; ++st) {
            if ((st ^ alt) == 0) { pg8::Gemm g{MIX, (const bf16*)(wl + WL_OUT), MT, DM, DM}; pg8::StaticOrder S; S.init(MP, DM, G, c);
                pg8::EpiRes E{XA, XB, ssq + (size_t)(3 * l + 1) * MT};
                pg8::gemm_phase<pg8::EpiRes, pg8::StaticOrder, true, true>(lds, g, S, E); }
            else { sg::SRes SE{XA, XB, ssq + (size_t)(3 * l + 1) * MT}; sg::small_gemm<false, 4, 2, sg::SRes>(lds, MIX, (const bf16*)(wl + WL_OUT), DM, DM, SE); } }
        GRID_BAR();
#pragma unroll 1
        for (int st = 0; st < 3; ++st) {
            if (st == 1) { pg8::Gemm g{XB, (const bf16*)(wl + WL_FF1), MT, DFF, DM}; pg8::StaticOrder S; S.init(MP, DFF, G, c);
                int tidp = threadIdx.x; asm volatile("" : "+v"(tidp));
                pg8::rs_preload((LAS float*)(lds + pg8::RS_OFF), ssq + (size_t)(3 * l + 1) * MT, S, tidp);
                pg8::EpiRelu2 E{Hb, ssq + (size_t)(3 * l + 1) * MT, (const LAS float*)(lds + pg8::RS_OFF), 0};
                pg8::gemm_phase<pg8::EpiRelu2, pg8::StaticOrder, true, true>(lds, g, S, E); }
            else { sg::SRelu2 SE{Hb, ssq + (size_t)(3 * l + 1) * MT}; sg::small_gemm<false, 4, 4, sg::SRelu2>(lds, XB, (const bf16*)(wl + WL_FF1), DFF, DM, SE, st == 0 ? 0 : cls3, st == 0 ? cls3 : (1 << 20)); } }
        GRID_BAR();
#pragma unroll 1
        for (int st = 0; st < 2; ++st) {
            if ((st ^ alt) == 0) { pg8::Gemm g{Hb, (const bf16*)(wl + WL_FF2), MT, DM, DFF}; pg8::StaticOrder S; S.init(MP, DM, G, c);
                pg8::EpiRes E{XB, XB, ssq + (size_t)(3 * l + 2) * MT};
                pg8::gemm_phase<pg8::EpiRes, pg8::StaticOrder, true, true>(lds, g, S, E); }
            else { sg::SRes SE{XB, XB, ssq + (size_t)(3 * l + 2) * MT}; sg::small_gemm<false, 4, 2, sg::SRes>(lds, Hb, (const bf16*)(wl + WL_FF2), DM, DFF, SE); } }
        GRID_BAR();
#pragma unroll 1
        for (int st = 0; st < 4; ++st) { const int op = (st + 2 * alt) & 3;
            if (op == 0) { pg8::Gemm g{(const bf16*)(ws + WS_PB) + (size_t)l * MT * PLE, (const bf16*)(wl + WL_PLE), MT, DM, PLE}; pg8::StaticOrder S; S.init(MP, DM, G, c);
                pg8::EpiQ E{Qb};
                pg8::gemm_phase<pg8::EpiQ, pg8::StaticOrder, true, true>(lds, g, S, E); }
            else if (op == 1) { pg8::Gemm g{XB, (const bf16*)(wl + WL_GATE), MT, DM, DM}; pg8::StaticOrder S; S.init(MP, DM, G, c);
                pg8::EpiGate E{Qb, XB, XA, ssq + (size_t)(3 * l + 2) * MT, ssq + (size_t)(3 * l + 3) * MT};
                pg8::gemm_phase<pg8::EpiGate, pg8::StaticOrder, true, true>(lds, g, S, E); }
            else if (op == 2) { sg::SQ SE{Qb}; sg::small_gemm<false, 1, 2, sg::SQ>(lds, (const bf16*)(ws + WS_PB) + (size_t)l * MT * PLE, (const bf16*)(wl + WL_PLE), DM, PLE, SE); }
            else { sg::SGate SE{Qb, XB, XA, ssq + (size_t)(3 * l + 2) * MT, ssq + (size_t)(3 * l + 3) * MT}; sg::small_gemm<false, 4, 2, sg::SGate>(lds, XB, (const bf16*)(wl + WL_GATE), DM, DM, SE); } }
        GRID_BAR();
    }
    { const int lane = threadIdx.x & 63, gw = blockIdx.x * NWAVES + (threadIdx.x >> 6), NGW = G * NWAVES; const pg8::ssq_t* sq = ssq + (size_t)12 * MT; const float* gf = a.in[I_GFINAL];
      for (int r0 = gw; r0 < MT; r0 += 2 * NGW) {
          v4u xw[2][2]; float rsv[2];
#pragma unroll
          for (int u = 0; u < 2; ++u) { const int r = r0 + u * NGW; if (r < MT) { rsv[u] = pg8::rs_of(sq, r); const v4u* xr = (const v4u*)(XA + (size_t)r * DM); xw[u][0] = xr[lane]; xw[u][1] = xr[lane + 64]; } }
#pragma unroll
          for (int u = 0; u < 2; ++u) { const int r = r0 + u * NGW; if (r < MT) { f32x4* yr = (f32x4*)(X + (size_t)r * DM);
#pragma unroll
              for (int j = 0; j < 2; ++j) { f32x4 v0, v1; pg8::unpack8(xw[u][j], v0, v1); const f32x4 g0 = *((const f32x4*)gf + 2 * (lane + 64 * j)), g1 = *((const f32x4*)gf + 2 * (lane + 64 * j) + 1);
                  yr[2 * (lane + 64 * j)] = v0 * rsv[u] * g0; yr[2 * (lane + 64 * j) + 1] = v1 * rsv[u] * g1; } } } } }
}

extern "C" void kernel_launch(void* const* d_in, const int* in_sizes, int n_in, void* d_out, int out_size, void* d_ws, size_t ws_size, hipStream_t stream) {
    static int grid = 0;
    if (grid == 0) {
        if (n_in != 22 || in_sizes[0] != MP * DM || (size_t)out_size != OUT_END || ws_size < WS_END) { fprintf(stderr, "kernel_launch: unexpected shapes (n_in %d, in0 %d, out %d, ws %zu; need ws >= %zu); nothing launched\n", n_in, n_in > 0 ? in_sizes[0] : -1, out_size, ws_size, (size_t)WS_END); grid = -1; return; }
        int dev = 0, cus = 0, per_cu = 0;
        if (hipGetDevice(&dev) != hipSuccess || hipDeviceGetAttribute(&cus, hipDeviceAttributeMultiprocessorCount, dev) != hipSuccess) { grid = -1; return; }
        if (hipFuncSetAttribute((const void*)mk_fwd, hipFuncAttributeMaxDynamicSharedMemorySize, LDS_BYTES) != hipSuccess) { fprintf(stderr, "kernel_launch: hipFuncSetAttribute failed\n"); grid = -1; return; }
        if (hipOccupancyMaxActiveBlocksPerMultiprocessor(&per_cu, (const void*)mk_fwd, NTHR, LDS_BYTES) != hipSuccess || per_cu < 1) { fprintf(stderr, "kernel_launch: occupancy query says %d\n", per_cu); per_cu = 1; }
        (void)hipGetLastError();
        grid = cus;
    }
    if (grid < 0) return;
    (void)hipMemsetAsync((char*)d_ws + WS_CTL, 0, CTL_ZERO_BYTES, stream);
    Args a{};
    for (int i = 0; i < 22; ++i) a.in[i] = (const float*)d_in[i];
    a.out = (float*)d_out; a.ws = (unsigned char*)d_ws;
    void* args[] = {&a};
    hipError_t e = hipLaunchCooperativeKernel((const void*)mk_fwd, dim3(grid), dim3(NTHR), args, LDS_BYTES, stream);
    if (e != hipSuccess) fprintf(stderr, "kernel_launch: cooperative launch failed: %s (grid %d)\n", hipGetErrorString(e), grid);
}
```
